# Optimizing an MI355X kernel written in HIP

```python
import jax, jax.numpy as jnp
from jax import lax
import numpy as np

D_MODEL = 1024
BATCH = 16
SEQ = 2048
DEPTH = 1

GRID_W = 64
N_HEADS = 8
N_KV_HEADS = 2
HEAD_DIM = 64
ATTN_WIDTH = N_HEADS * HEAD_DIM
KV_WIDTH = N_KV_HEADS * HEAD_DIM
CONV_WIDTH = 512
CONV_K = 3
ROPE_THETA = 10000.0
Q_BLOCK = 128
N_EXPERTS = 256
TOP_K = 8
N_GROUPS = 8
TOPK_GROUPS = 4
EXPERT_FF = 256
SHARED_FF = 256
ROUTED_SCALE = 2.5
EXPERT_BLOCK = 128
EPS = 1e-6
N_MOD = 6
_SIZES = (ATTN_WIDTH, KV_WIDTH, KV_WIDTH, CONV_WIDTH, CONV_WIDTH, CONV_WIDTH, D_MODEL, D_MODEL)
IN_COLS = sum(_SIZES)
SPLITS = tuple(int(v) for v in np.cumsum(_SIZES)[:-1])

kernel_name = "hybrid_gqa_shortconv_moe_adaln_block"


def rms_norm(x, g):
    xf = x.astype(jnp.float32)
    y = xf * lax.rsqrt(jnp.mean(xf * xf, axis=-1, keepdims=True) + EPS)
    return (y * g.astype(jnp.float32)).astype(x.dtype)


def axial_angles(seq_len):
    rows = seq_len // GRID_W
    row = jnp.repeat(jnp.arange(rows, dtype=jnp.int32), GRID_W).astype(jnp.float32)
    col = jnp.tile(jnp.arange(GRID_W, dtype=jnp.int32), rows).astype(jnp.float32)
    axis_dim = HEAD_DIM // 2
    inv_freq = ROPE_THETA ** (-jnp.arange(0, axis_dim, 2, dtype=jnp.float32) / axis_dim)
    return row[:, None] * inv_freq[None, :], col[:, None] * inv_freq[None, :]


def rope_rotate(x, ang):
    x1, x2 = jnp.split(x, 2, axis=-1)
    cos = jnp.cos(ang).astype(x.dtype)
    sin = jnp.sin(ang).astype(x.dtype)
    return jnp.concatenate([x1 * cos - x2 * sin, x2 * cos + x1 * sin], axis=-1)


def axial_rope(x, ang_r, ang_c):
    xr, xc = jnp.split(x, 2, axis=-1)
    return jnp.concatenate([rope_rotate(xr, ang_r), rope_rotate(xc, ang_c)], axis=-1)


def gqa_attention(q, k, v):
    b, h, s, dh = q.shape
    g = k.shape[1]
    rep = h // g
    nb = s // Q_BLOCK
    qb = q.reshape(b, g, rep, nb, Q_BLOCK, dh).transpose(3, 0, 1, 2, 4, 5)
    scale = dh ** -0.5

    def block(qi):
        sc = jnp.einsum('bgrqd,bgkd->bgrqk', qi, k).astype(jnp.float32) * scale
        p = jax.nn.softmax(sc, axis=-1).astype(v.dtype)
        return jnp.einsum('bgrqk,bgkd->bgrqd', p, v)

    o = lax.map(block, qb)
    return o.transpose(1, 0, 4, 2, 3, 5).reshape(b, s, h * dh)


def short_conv(u, w):
    ch = u.shape[-1]
    return lax.conv_general_dilated(
        u, w[:, None, :].astype(u.dtype), window_strides=(1,),
        padding=((CONV_K // 2, CONV_K // 2),),
        dimension_numbers=('NWC', 'WIO', 'NWC'), feature_group_count=ch)


def token_mixer(h, w_in, q_norm_g, k_norm_g, conv_w, w_attn_o, w_conv_o, w_out):
    b, s, _ = h.shape
    proj = h @ w_in
    q, k, v, cb, cc, cx, ga, gc = jnp.split(proj, SPLITS, axis=-1)
    q = q.reshape(b, s, N_HEADS, HEAD_DIM).transpose(0, 2, 1, 3)
    k = k.reshape(b, s, N_KV_HEADS, HEAD_DIM).transpose(0, 2, 1, 3)
    v = v.reshape(b, s, N_KV_HEADS, HEAD_DIM).transpose(0, 2, 1, 3)
    ang_r, ang_c = axial_angles(s)
    q = axial_rope(rms_norm(q, q_norm_g), ang_r, ang_c)
    k = axial_rope(rms_norm(k, k_norm_g), ang_r, ang_c)
    attn_d = gqa_attention(q, k, v) @ w_attn_o
    conv_d = (cb * short_conv(cc * cx, conv_w)) @ w_conv_o
    merged = jax.nn.sigmoid(ga) * attn_d + jax.nn.sigmoid(gc) * conv_d
    return merged @ w_out


def route(hf, w_router, router_bias):
    t = hf.shape[0]
    scores = jax.nn.sigmoid((hf @ w_router).astype(jnp.float32))
    biased = scores + router_bias.astype(jnp.float32)
    grp = biased.reshape(t, N_GROUPS, N_EXPERTS // N_GROUPS)
    grp_score = jnp.sum(lax.top_k(grp, 2)[0], axis=-1)
    _, grp_idx = lax.top_k(grp_score, TOPK_GROUPS)
    grp_mask = jnp.any(grp_idx[..., None] == jnp.arange(N_GROUPS), axis=-2)
    expert_mask = jnp.repeat(grp_mask, N_EXPERTS // N_GROUPS, axis=-1)
    _, idx = lax.top_k(jnp.where(expert_mask, biased, -jnp.inf), TOP_K)
    w = jnp.take_along_axis(scores, idx, axis=-1)
    w = w / jnp.sum(w, axis=-1, keepdims=True) * ROUTED_SCALE
    return idx, w


def routed_experts(hf, idx, w, w_gate_e, w_up_e, w_down_e):
    t, d = hf.shape
    n_assign = t * TOP_K
    e_flat = idx.reshape(-1)
    tok_flat = jnp.repeat(jnp.arange(t, dtype=jnp.int32), TOP_K)
    w_flat = w.reshape(-1)
    order = jnp.argsort(e_flat)
    e_sorted = e_flat[order]
    counts = jnp.bincount(e_flat, length=N_EXPERTS)
    starts = jnp.cumsum(counts) - counts
    padded = (counts + EXPERT_BLOCK - 1) // EXPERT_BLOCK * EXPERT_BLOCK
    pends = jnp.cumsum(padded)
    pstarts = pends - padded
    dest = pstarts[e_sorted] + (jnp.arange(n_assign) - starts[e_sorted])
    n_blocks = -(-(n_assign + N_EXPERTS * (EXPERT_BLOCK - 1)) // EXPERT_BLOCK)
    cap = n_blocks * EXPERT_BLOCK
    buf_tok = jnp.zeros((cap,), jnp.int32).at[dest].set(tok_flat[order])
    buf_w = jnp.zeros((cap,), w.dtype).at[dest].set(w_flat[order])
    block_e = jnp.searchsorted(pends, jnp.arange(n_blocks) * EXPERT_BLOCK, side='right')
    block_e = jnp.minimum(block_e, N_EXPERTS - 1)

    def block(args):
        tok, wb, e = args
        xb = hf[tok]
        hid = jax.nn.silu(xb @ w_gate_e[e]) * (xb @ w_up_e[e])
        return (hid @ w_down_e[e]) * wb[:, None].astype(xb.dtype)

    out = lax.map(block, (buf_tok.reshape(n_blocks, EXPERT_BLOCK),
                          buf_w.reshape(n_blocks, EXPERT_BLOCK), block_e))
    return jax.ops.segment_sum(out.reshape(cap, d), buf_tok, num_segments=t)


def setup_inputs(seed: int = 0) -> dict:
    key = jax.random.key(seed)
    ks = jax.random.split(key, 24)
    f32 = jnp.float32
    n = lambda k, shp, s: jax.random.normal(k, shp, f32) * s
    L, D = DEPTH, D_MODEL
    return {
        "x": n(ks[0], (BATCH, SEQ, D), 1.0),
        "c": n(ks[1], (BATCH, D), 1.0),
        "w_ada": n(ks[2], (L, D, N_MOD * D), 0.5 * D ** -0.5),
        "b_ada": n(ks[3], (L, N_MOD * D), 0.01),
        "g_norm_mix": 1.0 + n(ks[4], (L, D), 0.02),
        "w_in": n(ks[5], (L, D, IN_COLS), D ** -0.5),
        "q_norm_g": 1.0 + n(ks[6], (L, HEAD_DIM), 0.02),
        "k_norm_g": 1.0 + n(ks[7], (L, HEAD_DIM), 0.02),
        "conv_w": n(ks[8], (L, CONV_K, CONV_WIDTH), CONV_K ** -0.5),
        "w_attn_o": n(ks[9], (L, ATTN_WIDTH, D), ATTN_WIDTH ** -0.5),
        "w_conv_o": n(ks[10], (L, CONV_WIDTH, D), CONV_WIDTH ** -0.5),
        "w_out": n(ks[11], (L, D, D), D ** -0.5),
        "g_norm_ffn": 1.0 + n(ks[12], (L, D), 0.02),
        "w_router": n(ks[13], (L, D, N_EXPERTS), D ** -0.5),
        "router_bias": n(ks[14], (L, N_EXPERTS), 0.01),
        "w_gate_e": n(ks[15], (L, N_EXPERTS, D, EXPERT_FF), D ** -0.5),
        "w_up_e": n(ks[16], (L, N_EXPERTS, D, EXPERT_FF), D ** -0.5),
        "w_down_e": n(ks[17], (L, N_EXPERTS, EXPERT_FF, D), EXPERT_FF ** -0.5),
        "w_gate_s": n(ks[18], (L, D, SHARED_FF), D ** -0.5),
        "w_up_s": n(ks[19], (L, D, SHARED_FF), D ** -0.5),
        "w_down_s": n(ks[20], (L, SHARED_FF, D), SHARED_FF ** -0.5),
    }


def reference(x, c, w_ada, b_ada, g_norm_mix, w_in, q_norm_g, k_norm_g, conv_w, w_attn_o,
              w_conv_o, w_out, g_norm_ffn, w_router, router_bias, w_gate_e, w_up_e, w_down_e,
              w_gate_s, w_up_s, w_down_s):
    b, s, d = x.shape
    for l in range(DEPTH):
        mod = jax.nn.silu(c) @ w_ada[l] + b_ada[l]
        sh_a, sc_a, gt_a, sh_m, sc_m, gt_m = jnp.split(mod[:, None, :], N_MOD, axis=-1)
        h = rms_norm(x, g_norm_mix[l]) * (1 + sc_a) + sh_a
        x = x + gt_a * token_mixer(h, w_in[l], q_norm_g[l], k_norm_g[l], conv_w[l],
                                   w_attn_o[l], w_conv_o[l], w_out[l])
        h = rms_norm(x, g_norm_ffn[l]) * (1 + sc_m) + sh_m
        hf = h.reshape(b * s, d)
        idx, w = route(hf, w_router[l], router_bias[l])
        routed = routed_experts(hf, idx, w, w_gate_e[l], w_up_e[l], w_down_e[l])
        shared = (jax.nn.silu(hf @ w_gate_s[l]) * (hf @ w_up_s[l])) @ w_down_s[l]
        x = x + gt_m * (routed + shared).reshape(b, s, d)
    return x
```

```cpp
#include <hip/hip_runtime.h>
#include <hip/hip_cooperative_groups.h>
#include <hip/hip_bf16.h>
#include <cstdio>
#include <cstdint>
#include <cmath>
namespace cg = cooperative_groups;
#ifndef PHMASK
#define PHMASK 0x3fff
#endif

namespace pg8 {
#define PG8_LAS __attribute__((address_space(3)))
typedef unsigned short bf16_t;
typedef short bf16x8 __attribute__((ext_vector_type(8)));
typedef float f32x4 __attribute__((ext_vector_type(4)));
typedef unsigned u32x4 __attribute__((ext_vector_type(4)));
constexpr int BM = 256, BK = 64, HALF = 128, HTB = HALF * BK * 2  , STAGE_BYTES = 8 * HTB, NXCD = 8, WGM = 8;

__host__ __device__ __forceinline__ int lds_byte(int r, int c) { const int st = (r >> 4) * 2 + (c >> 5), rr = r & 15, cc = c & 31, ob = rr * 64 + cc * 2; return st * 1024 + (ob ^ (((ob >> 9) & 1) << 5)); }
__host__ __device__ __forceinline__ void stage_rc(int b, int& R, int& C) { const int st = b / 1024, sb = b % 1024, swz = sb ^ (((sb >> 9) & 1) << 5); R = (st >> 1) * 16 + swz / 64; C = (st & 1) * 32 + (swz % 64) / 2; }
__host__ __device__ __forceinline__ int perm32(int rho) { const int n = rho >> 4, i = rho & 15; return 8 * (i >> 2) + 4 * n + (i & 3); }

struct Unit { int pm, pn, pnb, aux; };
struct Gemm { const bf16_t* A; const bf16_t* Bt; int lda, K; const int* rowidx; };

struct StaticOrder {
    int nM, nN, nwg, G, c;
    __host__ __device__ void init(int M, int N, int G_, int c_) { nM = M / BM; nN = N / BM; nwg = nM * nN; G = G_; c = c_; }
    __host__ __device__ bool next(int i, Unit& u) const {
        const long L = (long)i * G + c; if (L >= nwg) return false;
        int wgid = (int)L; { const int q = nwg / NXCD, r = nwg % NXCD, xcd = wgid % NXCD, off = wgid / NXCD; wgid = (xcd < r ? xcd * (q + 1) : r * (q + 1) + (xcd - r) * q) + off; }
        const int nig = WGM * nN, gid = wgid / nig, fm = gid * WGM, gsz = (nM - fm) < WGM ? (nM - fm) : WGM;
        u.pm = fm + ((wgid % nig) % gsz); u.pn = (wgid % nig) / gsz; u.pnb = u.pn; u.aux = 0; return true;
    }
};
struct DynOrder {
    int nunits, G, c, NPN; const PG8_LAS int* tileE;
    __device__ __forceinline__ bool next(int i, Unit& u) const {
        const long L = (long)i * G + c; if (L >= nunits) return false;
        int id = (int)L; { const int q = nunits / NXCD, r = nunits % NXCD, xcd = id % NXCD, off = id / NXCD; id = (xcd < r ? xcd * (q + 1) : r * (q + 1) + (xcd - r) * q) + off; }
        const int tile = id / NPN, pn = id - tile * NPN; const int e = tileE[tile];
        u.pm = tile; u.pn = pn; u.pnb = e * NPN + pn; u.aux = e; return true;
    }
};

__device__ __forceinline__ unsigned cvt_pk_bf16(float lo, float hi) { unsigned r; asm volatile("v_cvt_pk_bf16_f32 %0, %1, %2" : "=v"(r) : "v"(lo), "v"(hi)); return r; }
__device__ __forceinline__ float bf_lo(unsigned w) { return __uint_as_float(w << 16); }
__device__ __forceinline__ float bf_hi(unsigned w) { return __uint_as_float(w & 0xffff0000u); }
__device__ __forceinline__ float sigmoid_f(float v) { return __builtin_amdgcn_rcpf(1.0f + __builtin_amdgcn_exp2f(-1.4426950408889634f * v)); }

template <class Epi, class Sched, bool GATHER>
__device__ __forceinline__ void gemm_phase(PG8_LAS unsigned char* lds, const Gemm g, const Sched& S, const Epi& E, int tid) {
    asm volatile("" : "+v"(tid));
    const int wid = __builtin_amdgcn_readfirstlane(tid >> 6), lane = tid & 63, wr = wid >> 2, wc = wid & 3, fr = lane & 15, fq = lane >> 4;
    int K_ = g.K; asm volatile("" : "+s"(K_));
    const int K = K_, nt = K / BK;
    int RA[2], CA2[2]; unsigned voffB[2];
#pragma unroll
    for (int i = 0; i < 2; ++i) { int R, C; stage_rc(tid * 16 + i * 8192, R, C); const int Rb = (R & ~31) + perm32(R & 31);
        RA[i] = R; CA2[i] = C * 2; voffB[i] = (unsigned)(Rb * K + C) * 2u; }
    const unsigned lda2 = (unsigned)g.lda * 2u;
    const size_t kstep = (size_t)(BK * 2);
    const size_t hstepB = (size_t)HALF * K * 2;
    const size_t tstepB = 2 * hstepB;
    const unsigned ldsw = (unsigned)wid * 1024u;
    const int aoff = lds_byte(wr * 64 + fr, fq * 8), boff = lds_byte(wc * 32 + fr, fq * 8);
#define PG8_SA(b, h) (((b) * 2 + (h)) * HTB)
#define PG8_SB(b, h) ((4 + (b) * 2 + (h)) * HTB)
#define PG8_STAGE2(bufoff, gbase, o0, o1) do { \
        __builtin_amdgcn_global_load_lds((const unsigned*)((const char*)(gbase) + (o0)), (PG8_LAS unsigned*)(lds + (bufoff) + ldsw), 16, 0, 0); \
        __builtin_amdgcn_global_load_lds((const unsigned*)((const char*)(gbase) + (o1)), (PG8_LAS unsigned*)(lds + (bufoff) + ldsw + 8192), 16, 0, 0); } while (0)
#define PG8_STAGEB(bufoff, gbase) PG8_STAGE2(bufoff, gbase, voffB[0], voffB[1])
#define PG8_AOFF(dst, u) do { _Pragma("unroll") for (int h_ = 0; h_ < 2; ++h_) _Pragma("unroll") for (int i_ = 0; i_ < 2; ++i_) { \
        int r_ = (u).pm * BM + h_ * HALF + RA[i_]; if constexpr (GATHER) r_ = g.rowidx[r_]; dst[h_][i_] = (unsigned)r_ * lda2 + (unsigned)CA2[i_]; } } while (0)
#define PG8_LDA(dst, b, h) do { _Pragma("unroll") for (int m = 0; m < 4; ++m) _Pragma("unroll") for (int k = 0; k < 2; ++k) dst[m][k] = *(const PG8_LAS bf16x8*)(lds + PG8_SA(b, h) + aoff + m * 2048 + k * 1024); } while (0)
#define PG8_LDB(dst, b, h) do { _Pragma("unroll") for (int n = 0; n < 2; ++n) _Pragma("unroll") for (int k = 0; k < 2; ++k) dst[n][k] = *(const PG8_LAS bf16x8*)(lds + PG8_SB(b, h) + boff + n * 2048 + k * 1024); } while (0)
#define PG8_MMA(ai, bj, At, Bt) do { __builtin_amdgcn_s_setprio(1); _Pragma("unroll") for (int m = 0; m < 4; ++m) _Pragma("unroll") for (int n = 0; n < 2; ++n) _Pragma("unroll") for (int k = 0; k < 2; ++k) \
        acc[ai][bj][m][n] = __builtin_amdgcn_mfma_f32_16x16x32_bf16(Bt[n][k], At[m][k], acc[ai][bj][m][n], 0, 0, 0); __builtin_amdgcn_s_setprio(0); } while (0)
#define PG8_WAIT_V(n) asm volatile("s_waitcnt vmcnt(" #n ")" ::: "memory")
#define PG8_WAIT_L(n) asm volatile("s_waitcnt lgkmcnt(" #n ")" ::: "memory")
#define PG8_BAR __builtin_amdgcn_s_barrier()
#define PG8_SCHED __builtin_amdgcn_sched_barrier(0)
    Unit cur, nxt; int ui = 0;
    if (!S.next(0, cur)) return;
    f32x4 acc[2][2][4][2];
#pragma unroll
    for (int a = 0; a < 2; ++a)
#pragma unroll
        for (int b = 0; b < 2; ++b)
#pragma unroll
            for (int m = 0; m < 4; ++m)
#pragma unroll
                for (int n = 0; n < 2; ++n) acc[a][b][m][n] = (f32x4){0.f, 0.f, 0.f, 0.f};
    bf16x8 At[4][2], B0[2][2], B1[2][2];
    unsigned ca[2][2], na[2][2];
    PG8_AOFF(ca, cur);
    const char* const Ab = (const char*)g.A;
    const char* cB = (const char*)g.Bt + (size_t)cur.pnb * tstepB;
    PG8_STAGEB(PG8_SB(0, 0), cB); PG8_STAGEB(PG8_SB(0, 1), cB + hstepB); PG8_STAGE2(PG8_SA(0, 0), Ab, ca[0][0], ca[0][1]); PG8_STAGE2(PG8_SA(0, 1), Ab, ca[1][0], ca[1][1]);
    if (wr == 1) PG8_BAR;
    PG8_WAIT_V(2); PG8_BAR;
    PG8_STAGEB(PG8_SB(1, 0), cB + kstep); PG8_STAGE2(PG8_SA(1, 0), Ab + kstep, ca[0][0], ca[0][1]); PG8_STAGEB(PG8_SB(1, 1), cB + hstepB + kstep);
    PG8_WAIT_V(6); PG8_BAR;
    for (;;) {
        const bool has_next = S.next(ui + 1, nxt);
        const char* nB = has_next ? (const char*)g.Bt + (size_t)nxt.pnb * tstepB : cB;
        if (has_next) { PG8_AOFF(na, nxt); } else { na[0][0] = ca[0][0]; na[0][1] = ca[0][1]; na[1][0] = ca[1][0]; na[1][1] = ca[1][1]; }
#pragma unroll 1
        for (int t = 0; t < nt; t += 2) {
            const bool last = (t == nt - 2);
            const char* a1 = Ab + (size_t)(t + 1) * kstep;
            const char* a2 = last ? Ab : Ab + (size_t)(t + 2) * kstep; const char* b2 = last ? nB : cB + (size_t)(t + 2) * kstep;
            const char* a3 = a2 + kstep; const char* b3 = b2 + kstep;
            const unsigned x00 = last ? na[0][0] : ca[0][0], x01 = last ? na[0][1] : ca[0][1], x10 = last ? na[1][0] : ca[1][0], x11 = last ? na[1][1] : ca[1][1];
            PG8_LDB(B0, 0, 0); PG8_LDB(B1, 0, 1); PG8_SCHED; PG8_LDA(At, 0, 0); PG8_STAGE2(PG8_SA(1, 1), a1, ca[1][0], ca[1][1]);
            PG8_WAIT_V(8); PG8_WAIT_L(0); PG8_BAR; PG8_MMA(0, 0, At, B0); PG8_MMA(0, 1, At, B1); PG8_BAR; PG8_SCHED;
            PG8_LDA(At, 0, 1); PG8_STAGEB(PG8_SB(0, 0), b2); PG8_STAGEB(PG8_SB(0, 1), b2 + hstepB); PG8_STAGE2(PG8_SA(0, 0), a2, x00, x01);
            PG8_WAIT_V(8); PG8_WAIT_L(0); PG8_BAR; PG8_MMA(1, 0, At, B0); PG8_MMA(1, 1, At, B1); PG8_BAR; PG8_SCHED;
            PG8_LDB(B0, 1, 0); PG8_LDB(B1, 1, 1); PG8_SCHED; PG8_LDA(At, 1, 0); PG8_STAGE2(PG8_SA(0, 1), a2, x10, x11);
            PG8_WAIT_V(8); PG8_WAIT_L(0); PG8_BAR; PG8_MMA(0, 0, At, B0); PG8_MMA(0, 1, At, B1); PG8_BAR; PG8_SCHED;
            PG8_LDA(At, 1, 1); PG8_STAGEB(PG8_SB(1, 0), b3); PG8_STAGEB(PG8_SB(1, 1), b3 + hstepB); PG8_STAGE2(PG8_SA(1, 0), a3, x00, x01);
            PG8_WAIT_V(8); PG8_WAIT_L(0); PG8_BAR; PG8_MMA(1, 0, At, B0); PG8_MMA(1, 1, At, B1); PG8_BAR; PG8_SCHED;
        }
        if (wr == 0) PG8_BAR;
        E(acc, cur, wr, wc, fr, fq);
        if (!has_next) break;
#pragma unroll
        for (int a = 0; a < 2; ++a)
#pragma unroll
            for (int b = 0; b < 2; ++b)
#pragma unroll
                for (int m = 0; m < 4; ++m)
#pragma unroll
                    for (int n = 0; n < 2; ++n) acc[a][b][m][n] = (f32x4){0.f, 0.f, 0.f, 0.f};
        cur = nxt; cB = nB; ++ui;
        ca[0][0] = na[0][0]; ca[0][1] = na[0][1]; ca[1][0] = na[1][0]; ca[1][1] = na[1][1];
        if (wr == 1) PG8_BAR;
    }
    PG8_WAIT_V(0);
    PG8_BAR;
#undef PG8_SA
#undef PG8_SB
#undef PG8_STAGE2
#undef PG8_STAGEB
#undef PG8_AOFF
#undef PG8_LDA
#undef PG8_LDB
#undef PG8_MMA
#undef PG8_WAIT_V
#undef PG8_WAIT_L
#undef PG8_BAR
#undef PG8_SCHED
}
typedef const f32x4 (&AccRef)[2][2][4][2];
__device__ __forceinline__ u32x4 pack8(f32x4 v0, f32x4 v1) { u32x4 w; w.x = cvt_pk_bf16(v0[0], v0[1]); w.y = cvt_pk_bf16(v0[2], v0[3]); w.z = cvt_pk_bf16(v1[0], v1[1]); w.w = cvt_pk_bf16(v1[2], v1[3]); return w; }
__device__ __forceinline__ void unpack8(u32x4 w, f32x4& v0, f32x4& v1) { v0 = (f32x4){bf_lo(w.x), bf_hi(w.x), bf_lo(w.y), bf_hi(w.y)}; v1 = (f32x4){bf_lo(w.z), bf_hi(w.z), bf_lo(w.w), bf_hi(w.w)}; }
__device__ __forceinline__ f32x4 sig4(f32x4 v) { return (f32x4){sigmoid_f(v[0]), sigmoid_f(v[1]), sigmoid_f(v[2]), sigmoid_f(v[3])}; }

struct EpiProj {
    bf16_t *Q, *Kb, *Vb, *CB, *CC, *CX, *SGA, *SGC;
    __device__ __forceinline__ void operator()(AccRef acc, const Unit& u, int wr, int wc, int fr, int fq) const {
        const int pn = u.pn; const int row0 = u.pm * BM + wr * 64 + fr;
#pragma unroll
        for (int bj = 0; bj < 2; ++bj) {
            bf16_t* base; int ld, c0; bool act = false;
            if (pn < 2)       { base = Q;  ld = 512; c0 = pn * 256 + bj * HALF; }
            else if (pn == 2) { base = bj == 0 ? Kb : Vb; ld = 128; c0 = 0; }
            else if (pn < 5)  { base = CB; ld = 512; c0 = (pn - 3) * 256 + bj * HALF; }
            else if (pn < 7)  { base = CC; ld = 512; c0 = (pn - 5) * 256 + bj * HALF; }
            else if (pn < 9)  { base = CX; ld = 512; c0 = (pn - 7) * 256 + bj * HALF; }
            else if (pn < 13) { base = SGA; ld = 1024; c0 = (pn - 9) * 256 + bj * HALF; act = true; }
            else              { base = SGC; ld = 1024; c0 = (pn - 13) * 256 + bj * HALF; act = true; }
            const int col = c0 + wc * 32 + 8 * fq;
#pragma unroll
            for (int ai = 0; ai < 2; ++ai)
#pragma unroll
                for (int m = 0; m < 4; ++m) { f32x4 v0 = acc[ai][bj][m][0], v1 = acc[ai][bj][m][1];
                    if (act) { v0 = sig4(v0); v1 = sig4(v1); }
                    *(u32x4*)(base + (size_t)(row0 + ai * HALF + m * 16) * ld + col) = pack8(v0, v1); }
        }
    }
};
template <bool ADD> struct EpiGate {
    const bf16_t* SG; bf16_t* MG;
    __device__ __forceinline__ void operator()(AccRef acc, const Unit& u, int wr, int wc, int fr, int fq) const {
        const int row0 = u.pm * BM + wr * 64 + fr, col0 = u.pn * BM + wc * 32 + 8 * fq;
#pragma unroll
        for (int ai = 0; ai < 2; ++ai)
#pragma unroll
            for (int m = 0; m < 4; ++m)
#pragma unroll
                for (int bj = 0; bj < 2; ++bj) { const size_t off = (size_t)(row0 + ai * HALF + m * 16) * 1024 + col0 + bj * HALF;
                    f32x4 g0, g1; unpack8(*(const u32x4*)(SG + off), g0, g1);
                    f32x4 v0 = g0 * acc[ai][bj][m][0], v1 = g1 * acc[ai][bj][m][1];
                    if (ADD) { f32x4 p0, p1; unpack8(*(const u32x4*)(MG + off), p0, p1); v0 += p0; v1 += p1; }
                    *(u32x4*)(MG + off) = pack8(v0, v1); }
    }
};
template <bool RMW> struct EpiResid {
    const float* Xin; float* Xout; const float* GT;
    __device__ __forceinline__ void operator()(AccRef acc, const Unit& u, int wr, int wc, int fr, int fq) const {
        const int row0 = u.pm * BM + wr * 64 + fr, col0 = u.pn * BM + wc * 32 + 8 * fq; const float* gt = GT + (size_t)(u.pm >> 3) * 6144;
#pragma unroll
        for (int bj = 0; bj < 2; ++bj) { const f32x4 t0 = *(const f32x4*)(gt + col0 + bj * HALF), t1 = *(const f32x4*)(gt + col0 + bj * HALF + 4);
#pragma unroll
            for (int ai = 0; ai < 2; ++ai)
#pragma unroll
                for (int m = 0; m < 4; ++m) { const size_t off = (size_t)(row0 + ai * HALF + m * 16) * 1024 + col0 + bj * HALF;
                    const f32x4 x0 = *(const f32x4*)(Xin + off), x1 = *(const f32x4*)(Xin + off + 4);
                    *(f32x4*)(Xout + off) = x0 + t0 * acc[ai][bj][m][0]; *(f32x4*)(Xout + off + 4) = x1 + t1 * acc[ai][bj][m][1]; }
        }
    }
};
__device__ __forceinline__ void swiglu_store(AccRef acc, bf16_t* H, int row0, int hc0) {
#pragma unroll
    for (int ai = 0; ai < 2; ++ai)
#pragma unroll
        for (int m = 0; m < 4; ++m) { f32x4 v[2];
#pragma unroll
            for (int n = 0; n < 2; ++n) { const f32x4 gg = acc[ai][0][m][n], uu = acc[ai][1][m][n]; v[n] = gg * sig4(gg) * uu; }
            *(u32x4*)(H + (size_t)(row0 + ai * HALF + m * 16) * 256 + hc0) = pack8(v[0], v[1]); }
}
struct EpiRouterShared {
    float* SC; bf16_t* HS;
    __device__ __forceinline__ void operator()(AccRef acc, const Unit& u, int wr, int wc, int fr, int fq) const {
        const int row0 = u.pm * BM + wr * 64 + fr;
        if (u.pn == 0) {
#pragma unroll
            for (int ai = 0; ai < 2; ++ai)
#pragma unroll
                for (int m = 0; m < 4; ++m)
#pragma unroll
                    for (int bj = 0; bj < 2; ++bj) { float* p = SC + (size_t)(row0 + ai * HALF + m * 16) * 256 + bj * HALF + wc * 32 + 8 * fq;
                        *(f32x4*)p = sig4(acc[ai][bj][m][0]); *(f32x4*)(p + 4) = sig4(acc[ai][bj][m][1]); }
        } else swiglu_store(acc, HS, row0, (u.pn - 1) * HALF + wc * 32 + 8 * fq);
    }
};
struct EpiExpert1 {
    bf16_t* HID;
    __device__ __forceinline__ void operator()(AccRef acc, const Unit& u, int wr, int wc, int fr, int fq) const { swiglu_store(acc, HID, u.pm * BM + wr * 64 + fr, u.pn * HALF + wc * 32 + 8 * fq); }
};
struct EpiExpert2 {
    bf16_t* Y;
    __device__ __forceinline__ void operator()(AccRef acc, const Unit& u, int wr, int wc, int fr, int fq) const {
        const int row0 = u.pm * BM + wr * 64 + fr, col0 = u.pn * BM + wc * 32 + 8 * fq;
#pragma unroll
        for (int ai = 0; ai < 2; ++ai)
#pragma unroll
            for (int m = 0; m < 4; ++m)
#pragma unroll
                for (int bj = 0; bj < 2; ++bj) *(u32x4*)(Y + (size_t)(row0 + ai * HALF + m * 16) * 1024 + col0 + bj * HALF) = pack8(acc[ai][bj][m][0], acc[ai][bj][m][1]);
    }
};
}
#include <hip/hip_bf16.h>
#include <cmath>
namespace attn_body {
using bf16=__hip_bfloat16;
using bf16x8=__attribute__((ext_vector_type(8)))short;
using s16x4=__attribute__((ext_vector_type(4)))short;
using f32x16=__attribute__((ext_vector_type(16)))float;
using u32x4=__attribute__((ext_vector_type(4)))unsigned;
constexpr int BATCH=16,NHEAD=8,SEQ=2048,D=64,QP=512,KP=128,OP=512,GQA=4;
constexpr int NW=8,QBLK=32,QB=QBLK*NW,KVBLK=64,NQB=SEQ/QB;
constexpr int ATTN_UNIT_ROWS=QB;
__device__ __forceinline__ int crow(int r,int hi){return (r&3)+8*(r>>2)+4*hi;}
#define SBAR() __builtin_amdgcn_sched_barrier(0)
constexpr int NSLOT=3, SLOTB=8192;
constexpr int LDS_K=0, LDS_V=NSLOT*SLOTB, LDS_WS=2*NSLOT*SLOTB, LDS_OST=LDS_WS+NW*64*4, LDS_BYTES=LDS_OST+NW*4096;
constexpr float C2=0.125f*1.4426950408889634f;
__device__ __forceinline__ void glds16(const void*gsrc,unsigned lds_dst){unsigned keep;
  asm volatile("s_mov_b32 %0, m0\n\ts_mov_b32 m0, %2\n\ts_nop 0\n\tglobal_load_lds_dwordx4 %1, off\n\ts_mov_b32 m0, %0":"=&s"(keep):"v"(gsrc),"s"(lds_dst):"memory");}
__device__ __forceinline__ float max3f(float a,float b,float c){float r;asm("v_max3_f32 %0, %1, %2, %3":"=v"(r):"v"(a),"v"(b),"v"(c));return r;}
__device__ __forceinline__ float max2f(float a,float b){float r;asm("v_max_f32_e32 %0, %1, %2":"=v"(r):"v"(a),"v"(b));return r;}
__device__ __forceinline__ float fadd_s(float a,float b){float r;asm("v_add_f32_e32 %0, %1, %2":"=v"(r):"v"(a),"v"(b));return r;}
__device__ __forceinline__ float fsub_s(float a,float b){float r;asm("v_sub_f32_e32 %0, %1, %2":"=v"(r):"v"(a),"v"(b));return r;}
typedef float f32x2_t __attribute__((ext_vector_type(2))); typedef __bf16 bf16x2_t __attribute__((ext_vector_type(2)));
__device__ __forceinline__ unsigned cvtpk_s(float lo,float hi){f32x2_t v={lo,hi};bf16x2_t b=__builtin_convertvector(v,bf16x2_t);return __builtin_bit_cast(unsigned,b);}
#define WAIT_BAR(N) asm volatile("s_waitcnt vmcnt(" #N ") lgkmcnt(0)\n\ts_barrier":::"memory")

__device__ __forceinline__ void qkt(f32x16&p0,f32x16&p1,const char*Kslot,const bf16x8*qr,const f32x16&negm,int r32,int hi){
  const char*kb=Kslot+hi*1024+r32*16;
  #pragma unroll
  for(int d0=0;d0<4;++d0){
    const bf16x8 b0=*reinterpret_cast<const bf16x8*>(kb+d0*2048);
    const bf16x8 b1=*reinterpret_cast<const bf16x8*>(kb+d0*2048+512);
    if(d0==0){p0=__builtin_amdgcn_mfma_f32_32x32x16_bf16(b0,qr[0],negm,0,0,0);p1=__builtin_amdgcn_mfma_f32_32x32x16_bf16(b1,qr[0],negm,0,0,0);}
    else{p0=__builtin_amdgcn_mfma_f32_32x32x16_bf16(b0,qr[d0],p0,0,0,0);p1=__builtin_amdgcn_mfma_f32_32x32x16_bf16(b1,qr[d0],p1,0,0,0);}}
}
typedef __attribute__((address_space(3))) const char* lds_cptr;
typedef short v4i16_t __attribute__((ext_vector_type(4)));
__device__ __forceinline__ void kload8(bf16x8*kf,lds_cptr kp){
  kf[0]=*(const __attribute__((address_space(3))) bf16x8*)(kp);      kf[1]=*(const __attribute__((address_space(3))) bf16x8*)(kp+512);
  kf[2]=*(const __attribute__((address_space(3))) bf16x8*)(kp+2048); kf[3]=*(const __attribute__((address_space(3))) bf16x8*)(kp+2560);
  kf[4]=*(const __attribute__((address_space(3))) bf16x8*)(kp+4096); kf[5]=*(const __attribute__((address_space(3))) bf16x8*)(kp+4608);
  kf[6]=*(const __attribute__((address_space(3))) bf16x8*)(kp+6144); kf[7]=*(const __attribute__((address_space(3))) bf16x8*)(kp+6656);
}
__device__ __forceinline__ void kload2(bf16x8*kf,lds_cptr kp,int j){ kf[2*j]=*(const __attribute__((address_space(3))) bf16x8*)(kp+j*2048); kf[2*j+1]=*(const __attribute__((address_space(3))) bf16x8*)(kp+j*2048+512); }
__device__ __forceinline__ s16x4 vtr(lds_cptr p){ return __builtin_bit_cast(s16x4,__builtin_amdgcn_ds_read_tr16_b64_v4i16((__attribute__((address_space(3))) v4i16_t*)p)); }
__device__ __forceinline__ float rowmax(const f32x16&p0,const f32x16&p1){
  float a=max3f(p0[0],p0[1],p1[0]),b=max3f(p0[2],p0[3],p1[1]);a=max3f(a,p1[2],p1[3]);
  #pragma unroll
  for(int r=4;r<16;r+=4){a=max3f(a,p0[r],p0[r+1]);b=max3f(b,p0[r+2],p0[r+3]);a=max3f(a,p1[r],p1[r+1]);b=max3f(b,p1[r+2],p1[r+3]);}
  const float m=max2f(a,b);
  auto rr=__builtin_amdgcn_permlane32_swap(__float_as_uint(m),__float_as_uint(m),false,false);
  return max2f(__uint_as_float(rr[0]),__uint_as_float(rr[1]));
}
__device__ __forceinline__ void pv(f32x16*o,int vb,bf16x8 pa0,bf16x8 pa1,bf16x8 pa2,bf16x8 pa3){
  #pragma unroll
  for(int d0=0;d0<2;++d0){s16x4 lo[4],hi[4];
    #pragma unroll
    for(int ks=0;ks<4;++ks){
      asm volatile("ds_read_b64_tr_b16 %0,%1 offset:%c2":"=&v"(lo[ks]):"v"(vb),"i"(d0*4096+ks*1024):"memory");
      asm volatile("ds_read_b64_tr_b16 %0,%1 offset:%c2":"=&v"(hi[ks]):"v"(vb),"i"(d0*4096+ks*1024+512):"memory");}
    asm volatile("s_waitcnt lgkmcnt(0)":::"memory");SBAR();
    #define PK(k) (bf16x8){lo[k][0],lo[k][1],lo[k][2],lo[k][3],hi[k][0],hi[k][1],hi[k][2],hi[k][3]}
    o[d0]=__builtin_amdgcn_mfma_f32_32x32x16_bf16(pa0,PK(0),o[d0],0,0,0);
    o[d0]=__builtin_amdgcn_mfma_f32_32x32x16_bf16(pa1,PK(1),o[d0],0,0,0);
    o[d0]=__builtin_amdgcn_mfma_f32_32x32x16_bf16(pa2,PK(2),o[d0],0,0,0);
    o[d0]=__builtin_amdgcn_mfma_f32_32x32x16_bf16(pa3,PK(3),o[d0],0,0,0);
    #undef PK
  }
}

#ifndef ATTN_STORE16
#define ATTN_STORE16(p,v) (*(u32x4*)(p)=(v))
#endif
template<int THRL> __device__ __forceinline__ void attn_unit(int b,int h,int qb,const bf16*Q,const bf16*__restrict__ K,const bf16*__restrict__ V,bf16*O,char*shm,const int tid){
  const int lane=tid&63,r32=lane&31,hi=lane>>5; const int wid=__builtin_amdgcn_readfirstlane(tid>>6);
  const long rowbase=(long)b*SEQ; const int q0=qb*QB;
  const bf16*Qw=Q+(rowbase+q0+wid*QBLK)*QP+h*D;
  const bf16*Kh=K+rowbase*KP+(h/GQA)*D,*Vh=V+rowbase*KP+(h/GQA)*D;
  const unsigned lds0=(unsigned)(uintptr_t)shm;
  float*wsf=(float*)(shm+LDS_WS)+wid*64;
  const bf16*ksrc=Kh+(long)lane*KP+wid*8;
  const bf16*vsrc=Vh+(long)(16*(wid&3)+(lane>>2))*KP+(wid>>2)*32+(lane&3)*8;
  const unsigned kdst=lds0+LDS_K+wid*1024, vdst=lds0+LDS_V+wid*1024;
  #define DMA_K(t,slot) glds16(ksrc+(long)(t)*KVBLK*KP,(unsigned)__builtin_amdgcn_readfirstlane(kdst+(slot)))
  #define DMA_V(t,slot) glds16(vsrc+(long)(t)*KVBLK*KP,(unsigned)__builtin_amdgcn_readfirstlane(vdst+(slot)))
  const int vb0=(int)(lds0+LDS_V)+((lane>>4)&1)*32+(lane&3)*8+(4*hi+((lane&15)>>2))*64;
  const char*Kbase=shm+LDS_K; bf16x8 kf[8];
  const lds_cptr shm3=(lds_cptr)shm; const lds_cptr kp0=shm3+LDS_K+hi*1024+r32*16; const lds_cptr vp0=shm3+LDS_V+((lane>>4)&1)*32+(lane&3)*8+(4*hi+((lane&15)>>2))*64;
  const int NT=SEQ/KVBLK;
  DMA_K(0,0);DMA_V(0,0);DMA_K(1,SLOTB);
  bf16x8 qr[4];
  #pragma unroll
  for(int d0=0;d0<4;++d0)qr[d0]=*reinterpret_cast<const bf16x8*>(&Qw[(long)r32*QP+d0*16+hi*8]);
  float mhat=0.f,l_reg=0.f;f32x16 o[2];o[0]=f32x16{};o[1]=f32x16{};f32x16 negm=f32x16{};asm volatile("":"+v"(negm));
    #define CMASK(P0,P1,t) do{}while(0)
  bool resc=false;
  #define START(P0,P1) do{ const float rm=rowmax(P0,P1); resc=false; \
    { const float dl=rm; mhat=fadd_s(mhat,dl); \
      _Pragma("unroll") for(int r=0;r<16;++r){P0[r]=fsub_s(P0[r],dl);P1[r]=fsub_s(P1[r],dl);} \
      _Pragma("unroll") for(int r=0;r<16;++r)negm[r]=-mhat; asm volatile("":"+v"(negm)); } \
    _Pragma("unroll") for(int r=0;r<16;++r)P0[r]=__builtin_amdgcn_exp2f(P0[r]); }while(0)
  #define RESC() do{ if(resc){ asm volatile("s_waitcnt lgkmcnt(0)":::"memory"); \
      _Pragma("unroll") for(int d_=0;d_<2;++d_) _Pragma("unroll") for(int r=0;r<16;++r)o[d_][r]*=wsf[crow(r,hi)]; } }while(0)
  f32x16 pA0,pA1,pB0,pB1;
  int sl_prev=0,sl_cur=0,sl_next=SLOTB;
  #define ROT() do{sl_prev=sl_cur;sl_cur=sl_next;sl_next=(sl_next==(NSLOT-1)*SLOTB)?0:sl_next+SLOTB;}while(0)
  DMA_K(2,2*SLOTB);
  WAIT_BAR(3);
  qkt(pA0,pA1,Kbase,qr,negm,r32,hi);asm volatile("s_nop 15\n\ts_nop 7":"+v"(pA0),"+v"(pA1));CMASK(pA0,pA1,0);
  START(pA0,pA1);
  _Pragma("unroll") for(int r=0;r<16;++r)pA1[r]=__builtin_amdgcn_exp2f(pA1[r]);
  WAIT_BAR(0);
  DMA_K(3,0);DMA_V(1,SLOTB);
  ROT();
  kload8(kf,kp0+sl_cur);
  WAIT_BAR(2);
  s16x4 vlo[8],vhi[8]; u32x4 pw0,pw1,pw2,pw3;
  #define PKW(P,B) cvtpk_s(P[B],P[B+1])
  #define PAF(k) __builtin_bit_cast(bf16x8,pw##k)
  #define VFR(i) (bf16x8){vlo[i][0],vlo[i][1],vlo[i][2],vlo[i][3],vhi[i][0],vhi[i][1],vhi[i][2],vhi[i][3]}
  #define PIN(x) asm volatile("":"+v"(x))
  #define MX3(a,b,c) __builtin_fmaxf(__builtin_fmaxf((a),(b)),(c))
  #define GAPA(MF,A0,A1,A2,A3,W0,W1,PW) do{ MF; sacc+=A0; sacc+=A1; sacc+=A2; sacc+=A3; PIN(sacc); W0; W1; PIN(PW); SBAR(); }while(0)
  #define EX(v) __builtin_amdgcn_exp2f(v)
  #define GAPB(MF,X,B) do{ MF; X[B]=EX(X[B]); X[B+1]=EX(X[B+1]); X[B+2]=EX(X[B+2]); X[B+3]=EX(X[B+3]); PIN(X); SBAR(); }while(0)
  #define VRD(i) do{ vlo[i]=vtr(vp_+(((i)>>2)*4096+((i)&3)*1024)); vhi[i]=vtr(vp_+(((i)>>2)*4096+((i)&3)*1024+512)); }while(0)
  #define KRD(G,j) do{ if(G){ kload2(kf,kp0+sl_next,j); SBAR(); } }while(0)
  #define STEP(C0,C1,P0,P1,t,GK,GV,GL) do{ SBAR(); \
    const lds_cptr vp_=vp0+sl_prev; \
    VRD(0); SBAR(); float sacc=(P0[0]+P0[1]); \
    GAPA(C0=__builtin_amdgcn_mfma_f32_32x32x16_bf16(kf[0],qr[0],negm,0,0,0), P0[2],P0[3],P0[4],P0[5],     pw0[0]=PKW(P0,0), pw0[1]=PKW(P0,2), pw0); \
    VRD(4); SBAR(); GAPA(C1=__builtin_amdgcn_mfma_f32_32x32x16_bf16(kf[1],qr[0],negm,0,0,0), P0[6],P0[7],P0[8],P0[9],     pw0[2]=PKW(P0,4), pw0[3]=PKW(P0,6), pw0); \
    VRD(1); SBAR(); GAPA(C0=__builtin_amdgcn_mfma_f32_32x32x16_bf16(kf[2],qr[1],C0,0,0,0),   P0[10],P0[11],P0[12],P0[13], pw1[0]=PKW(P0,8), pw1[1]=PKW(P0,10), pw1); \
    VRD(5); SBAR(); GAPA(C1=__builtin_amdgcn_mfma_f32_32x32x16_bf16(kf[3],qr[1],C1,0,0,0),   P0[14],P0[15],P1[0],P1[1],   pw1[2]=PKW(P0,12),pw1[3]=PKW(P0,14), pw1); \
    VRD(2); SBAR(); GAPA(C0=__builtin_amdgcn_mfma_f32_32x32x16_bf16(kf[4],qr[2],C0,0,0,0),   P1[2],P1[3],P1[4],P1[5],     pw2[0]=PKW(P1,0), pw2[1]=PKW(P1,2), pw2); \
    VRD(6); SBAR(); GAPA(C1=__builtin_amdgcn_mfma_f32_32x32x16_bf16(kf[5],qr[2],C1,0,0,0),   P1[6],P1[7],P1[8],P1[9],     pw2[2]=PKW(P1,4), pw2[3]=PKW(P1,6), pw2); \
    VRD(3); SBAR(); GAPA(C0=__builtin_amdgcn_mfma_f32_32x32x16_bf16(kf[6],qr[3],C0,0,0,0),   P1[10],P1[11],P1[12],P1[13], pw3[0]=PKW(P1,8), pw3[1]=PKW(P1,10), pw3); \
    VRD(7); SBAR(); GAPA(C1=__builtin_amdgcn_mfma_f32_32x32x16_bf16(kf[7],qr[3],C1,0,0,0),   P1[14],P1[15],0.f,0.f,       pw3[2]=PKW(P1,12),pw3[3]=PKW(P1,14), pw3); \
    l_reg+=sacc; \
    if(GK){DMA_K((t)+3,sl_cur);} if(GV){DMA_V((t)+1,sl_next);} \
    CMASK(C0,C1,t); \
    { float a=MX3(C0[0],C0[1],C1[0]),b=MX3(C0[2],C0[3],C1[1]); a=MX3(a,C1[2],C1[3]); \
      _Pragma("unroll") for(int r=4;r<16;r+=4){a=MX3(a,C0[r],C0[r+1]);b=MX3(b,C0[r+2],C0[r+3]);a=MX3(a,C1[r],C1[r+1]);b=MX3(b,C1[r+2],C1[r+3]);} \
      float rm=__builtin_fmaxf(a,b); { auto rr=__builtin_amdgcn_permlane32_swap(__float_as_uint(rm),__float_as_uint(rm),false,false); rm=__builtin_fmaxf(__uint_as_float(rr[0]),__uint_as_float(rr[1])); } \
      resc=false; \
      if(__builtin_expect(__any(rm>(float)THRL),0)){ const float dl=__builtin_fmaxf(rm,0.f); mhat+=dl; \
        _Pragma("unroll") for(int r=0;r<16;++r){C0[r]-=dl;C1[r]-=dl;} \
        _Pragma("unroll") for(int r=0;r<16;++r)negm[r]=-mhat; asm volatile("":"+v"(negm)); \
        const float f=__builtin_amdgcn_exp2f(-dl); l_reg*=f; if(hi==0)wsf[r32]=f; resc=true; } } \
    SBAR(); \
    GAPB(o[0]=__builtin_amdgcn_mfma_f32_32x32x16_bf16(PAF(0),VFR(0),o[0],0,0,0), C0,0); \
    GAPB(o[1]=__builtin_amdgcn_mfma_f32_32x32x16_bf16(PAF(0),VFR(4),o[1],0,0,0), C0,4); \
    KRD(GL,0); GAPB(o[0]=__builtin_amdgcn_mfma_f32_32x32x16_bf16(PAF(1),VFR(1),o[0],0,0,0), C0,8); \
    KRD(GL,1); GAPB(o[1]=__builtin_amdgcn_mfma_f32_32x32x16_bf16(PAF(1),VFR(5),o[1],0,0,0), C0,12); \
    KRD(GL,2); GAPB(o[0]=__builtin_amdgcn_mfma_f32_32x32x16_bf16(PAF(2),VFR(2),o[0],0,0,0), C1,0); \
    KRD(GL,3); GAPB(o[1]=__builtin_amdgcn_mfma_f32_32x32x16_bf16(PAF(2),VFR(6),o[1],0,0,0), C1,4); \
    GAPB(o[0]=__builtin_amdgcn_mfma_f32_32x32x16_bf16(PAF(3),VFR(3),o[0],0,0,0), C1,8); \
    GAPB(o[1]=__builtin_amdgcn_mfma_f32_32x32x16_bf16(PAF(3),VFR(7),o[1],0,0,0), C1,12); \
    }while(0)
  int t=1;
  #undef CMASK
  #define CMASK(P0,P1,t) do{}while(0)
  for(;t+5<NT;t+=2){
    STEP(pB0,pB1,pA0,pA1,t,true,true,true);     WAIT_BAR(2); RESC(); ROT();
    STEP(pA0,pA1,pB0,pB1,t+1,true,true,true);   WAIT_BAR(2); RESC(); ROT();
  }
  #undef CMASK
  #define CMASK(P0,P1,t) do{}while(0)
  #define ENDW(tt) do{ if((tt)+3<NT){WAIT_BAR(2);} else if((tt)+2<NT){WAIT_BAR(1);} else {WAIT_BAR(0);} }while(0)
  for(;t+1<NT;t+=2){
    STEP(pB0,pB1,pA0,pA1,t,(t+3<NT),(t+1<NT),(t+1<NT));       ENDW(t);   RESC(); ROT();
    STEP(pA0,pA1,pB0,pB1,t+1,(t+4<NT),(t+2<NT),(t+2<NT));     ENDW(t+1); RESC(); ROT();
  }
  STEP(pB0,pB1,pA0,pA1,NT-1,false,false,false); RESC();
  { float sacc=pB0[0]+pB0[1]; _Pragma("unroll") for(int r=2;r<16;++r)sacc+=pB0[r]; _Pragma("unroll") for(int r=0;r<16;++r)sacc+=pB1[r]; l_reg+=sacc;
    pw0=(u32x4){PKW(pB0,0),PKW(pB0,2),PKW(pB0,4),PKW(pB0,6)};pw1=(u32x4){PKW(pB0,8),PKW(pB0,10),PKW(pB0,12),PKW(pB0,14)};pw2=(u32x4){PKW(pB1,0),PKW(pB1,2),PKW(pB1,4),PKW(pB1,6)};pw3=(u32x4){PKW(pB1,8),PKW(pB1,10),PKW(pB1,12),PKW(pB1,14)};
    SBAR(); pv(o,vb0+sl_cur,PAF(0),PAF(1),PAF(2),PAF(3)); }
  #undef PKW
  #undef PAF
  #undef VFR
  #undef PIN
  #undef MX3
  #undef GAPA
  #undef GAPB
  #undef EX
  #undef VRD
  #undef KRD
  #undef STEP
  #undef ENDW
  {auto rr=__builtin_amdgcn_permlane32_swap(__float_as_uint(l_reg),__float_as_uint(l_reg),false,false);l_reg=__uint_as_float(rr[0])+__uint_as_float(rr[1]);}
  if(hi==0)wsf[32+r32]=l_reg;asm volatile("s_waitcnt lgkmcnt(0)":::"memory");
  float rli[16];
  #pragma unroll
  for(int r=0;r<16;++r)rli[r]=__builtin_amdgcn_rcpf(wsf[32+crow(r,hi)]);
  bf16*Ow=O+(rowbase+q0+wid*QBLK)*OP+h*D;
  { bf16*stg=(bf16*)(shm+LDS_OST)+wid*2048;
    #pragma unroll
    for(int r=0;r<16;++r){const int orow=crow(r,hi);
      #pragma unroll
      for(int d0=0;d0<2;++d0)stg[orow*64+d0*32+r32]=__float2bfloat16(o[d0][r]*rli[r]);}
    asm volatile("s_waitcnt lgkmcnt(0)":::"memory");
    #pragma unroll
    for(int i=0;i<4;++i){const int row=i*8+(lane>>3),ch=lane&7; const u32x4 v=*(const u32x4*)(stg+row*64+ch*8); ATTN_STORE16(Ow+(long)row*OP+ch*8,v);} }
  asm volatile("s_waitcnt lgkmcnt(0)\n\ts_barrier":::"memory");
  #undef DMA_K
  #undef DMA_V
  #undef CMASK
  #undef START
  #undef RESC
  #undef ROT
}
constexpr int ATTN_LDS_BYTES=LDS_BYTES;
struct AttnTensors { const bf16* Q; const bf16* K; const bf16* V; bf16* O; };
struct AttnUnit { int bh; int qb; };
struct StaticOrder {
  int vcu;
  __device__ __forceinline__ explicit StaticOrder(int grid,int block):vcu((block%8)*(grid/8)+block/8){}
  __device__ __forceinline__ bool next(int i,AttnUnit&u)const{ if(i>=4)return false; const int pair=vcu>>3; u.bh=(pair>>1)*NHEAD+(pair&1)*GQA+i; u.qb=vcu&7; return true; }
  __device__ __forceinline__ void a_ready(const AttnUnit&)const{}
  __device__ __forceinline__ void done(const AttnUnit&)const{}
};
template<class Sched,int THRL=8> __device__ __forceinline__ void attn_phase(char*lds,const AttnTensors&T,const Sched&S,const int tid){
  AttnUnit u;
  for(int i=0;S.next(i,u);++i){ S.a_ready(u); attn_unit<THRL>(u.bh/NHEAD,u.bh%NHEAD,u.qb,T.Q,T.K,T.V,T.O,lds,tid); S.done(u); }
}
#undef SBAR
#undef WAIT_BAR
}
#define GAS __attribute__((address_space(1)))
#define LAS __attribute__((address_space(3)))
typedef unsigned short bf16;
typedef unsigned v4u __attribute__((ext_vector_type(4)));
typedef float f32x4 __attribute__((ext_vector_type(4)));
typedef GAS unsigned gu32;
#define RLX_AGENT __ATOMIC_RELAXED, __HIP_MEMORY_SCOPE_AGENT
#define LDS_WAIT() asm volatile("s_waitcnt lgkmcnt(0)" ::: "memory")

constexpr int NWAVES = 8;
constexpr int DM = 1024, NB = 16, SEQ = 2048, T = NB * SEQ;
constexpr int IN_COLS = 4352, NMOD = 6 * DM;
constexpr int NEXP = 256, TOPK = 8, EFF = 256;
constexpr int NSLOT_MAX = T * TOPK + NEXP * 255;
constexpr int NTILE_MAX = NSLOT_MAX / 256;
constexpr float EPS = 1e-6f, ROUTED_SCALE = 2.5f;
static_assert(NSLOT_MAX % 256 == 0, "slot space");

constexpr size_t MiB = 1u << 20;
constexpr size_t WS_CTL = 0, CTL_ZERO_BYTES = 64 * 1024;
constexpr size_t WS_MOD = 1 * MiB;
constexpr size_t WS_TBL = 1 * MiB + 512 * 1024;
constexpr size_t WS_TILE_E = WS_TBL + 16 * 1024;
constexpr size_t WS_IDX = 2 * MiB, WS_WTS = 3 * MiB, WS_SLOT = 4 * MiB;
constexpr size_t WS_SLOT_TOK = 5 * MiB;
constexpr size_t WS_HIST = 7 * MiB;
constexpr size_t WS_WIN = 16 * MiB;
constexpr size_t WS_WAO = 25 * MiB, WS_WCO = 26 * MiB;
constexpr size_t WS_WOUT = 27 * MiB;
constexpr size_t WS_WRS = 29 * MiB;
constexpr size_t WS_WSD = 31 * MiB;
constexpr size_t WS_WED = 32 * MiB;
constexpr size_t WS_HID = 160 * MiB;
constexpr size_t WS_H = 320 * MiB;
constexpr size_t WS_WE1 = 384 * MiB;
constexpr size_t WS_Q = 640 * MiB, WS_K = 672 * MiB, WS_V = 680 * MiB;
constexpr size_t WS_CB = 688 * MiB, WS_CC = 720 * MiB, WS_CX = 752 * MiB;
constexpr size_t WS_SGA = 784 * MiB, WS_SGC = 848 * MiB;
constexpr size_t WS_MG = 912 * MiB;
constexpr size_t WS_SC = 976 * MiB;
constexpr size_t WS_HS = 1008 * MiB;
constexpr size_t WS_Y = 384 * MiB;
constexpr size_t WS_O = WS_Q;
constexpr size_t WS_END = 1024 * MiB;
static_assert(WS_HID + (size_t)NSLOT_MAX * 512 <= WS_H && WS_Y + (size_t)NSLOT_MAX * 2048 <= WS_END && WS_SLOT_TOK + (size_t)NSLOT_MAX * 4 <= WS_HIST, "d_ws map");
constexpr int CW_NTILES = 16, CW_BAR = 4096;

constexpr int RING_BYTES = 131072, MISC_OFF = RING_BYTES, LDS_BYTES = 147456;
constexpr int L_HIST = 0, L_PAD = 1024, L_BASE = 2048, L_PS = 3072, L_BARST = 4112, L_TILEE = 4352;
static_assert(MISC_OFF + L_TILEE + (NTILE_MAX + 1) * 4 <= LDS_BYTES, "LDS map");

struct Args {
    const float *x, *c, *w_ada, *b_ada, *g_mix, *w_in, *qg, *kg, *conv_w, *w_attn_o, *w_conv_o, *w_out, *g_ffn, *w_router, *r_bias, *w_gate_e, *w_up_e, *w_down_e, *w_gate_s, *w_up_s, *w_down_s;
    float* out; unsigned char* ws;
};

template <int MASK> __device__ __forceinline__ unsigned swz_xor_u(unsigned v) { return (unsigned)__builtin_amdgcn_ds_swizzle((int)v, (MASK << 10) | 0x1f); }
template <int MASK> __device__ __forceinline__ float swz_xor_f(float v) { return __uint_as_float(swz_xor_u<MASK>(__float_as_uint(v))); }
__device__ __forceinline__ float wave_sum(float v) {
    v += swz_xor_f<1>(v); v += swz_xor_f<2>(v); v += swz_xor_f<4>(v); v += swz_xor_f<8>(v); v += swz_xor_f<16>(v);
    auto rr = __builtin_amdgcn_permlane32_swap(__float_as_uint(v), __float_as_uint(v), false, false);
    return __uint_as_float(rr[0]) + __uint_as_float(rr[1]);
}
__device__ __forceinline__ float bcast_f(float v, int srclane) { return __int_as_float(__builtin_amdgcn_readlane(__float_as_int(v), srclane)); }
__device__ __forceinline__ unsigned pk2(float lo, float hi) { return pg8::cvt_pk_bf16(lo, hi); }

#define XB_TMO      128
#define XB_XCNT(j)  (256  + 64 * (j))
#define XB_XSUB(j)  (1280 + 64 * (j))
#define XB_XGEN(j)  (2304 + 64 * (j))
#define XB_TOP      3328
#define XB_TOPGEN   3392
#define XCD_BAR_WORDS 3456
#define XB_SPIN_CAP (1u << 18)

__device__ __forceinline__ unsigned xb_ld(unsigned* p)              { return __hip_atomic_load(p, __ATOMIC_RELAXED, __HIP_MEMORY_SCOPE_AGENT); }
__device__ __forceinline__ unsigned xb_add(unsigned* p, unsigned v) { return __hip_atomic_fetch_add(p, v, __ATOMIC_RELAXED, __HIP_MEMORY_SCOPE_AGENT); }
__device__ __forceinline__ unsigned xb_xcc_id() { return (unsigned)__builtin_amdgcn_s_getreg((3 << 11) | 20) & 0xFu; }
#define XB_SPIN(cond, bar) do { unsigned _sp = 0; while (cond) { __builtin_amdgcn_s_sleep(1); \
    if ((++_sp & 255u) == 0u) { if (xb_ld(&(bar)[XB_TMO])) break; if (_sp > XB_SPIN_CAP) { atomicAdd(&(bar)[XB_TMO], 1u); break; } } } } while (0)

struct XcdBarrier {
    unsigned* bar; unsigned x;
    volatile LAS unsigned* st;
};

__device__ __forceinline__ XcdBarrier xcd_barrier_post(unsigned* bar, volatile LAS unsigned* st, int tid) {
    XcdBarrier b; b.bar = bar; b.x = xb_xcc_id(); b.st = st;
    if (tid == 0) (void)xb_add(&bar[XB_XCNT(b.x)], 1u);
    return b;
}
__device__ __forceinline__ void xcd_barrier_complete(unsigned* bar, unsigned x, unsigned& nloc, unsigned& nx) {
    const unsigned G = gridDim.x * gridDim.y * gridDim.z;
    unsigned sum, cnt, mine, sp = 0u;
    for (;;) {
        sum = 0u; cnt = 0u; mine = 0u;
#pragma unroll
        for (unsigned j = 0; j < 16; ++j) { const unsigned c = xb_ld(&bar[XB_XCNT(j)]); sum += c; cnt += (c > 0u) ? 1u : 0u; mine = (j == x) ? c : mine; }
        if (sum == G) break;
        __builtin_amdgcn_s_sleep(1);
        if ((++sp & 255u) == 0u) { if (xb_ld(&bar[XB_TMO])) break; if (sp > XB_SPIN_CAP) { atomicAdd(&bar[XB_TMO], 1u); break; } }
    }
    nloc = mine > 0u ? mine : 1u; nx = cnt > 0u ? cnt : 1u;
}

__device__ __forceinline__ void xcd_barrier(const XcdBarrier& b, int tid) {
    asm volatile("s_waitcnt vmcnt(0)" ::: "memory");
    __syncthreads();
    if (tid == 0) {
        unsigned* bar = b.bar;
        __builtin_amdgcn_s_waitcnt(0);
        unsigned nloc = b.st[0], nx = b.st[1];
        if (nloc == 0u) { xcd_barrier_complete(bar, b.x, nloc, nx); b.st[0] = nloc; b.st[1] = nx; }
        const unsigned old = xb_add(&bar[XB_XSUB(b.x)], 1u);
        const unsigned gen = old / nloc;
        if (old + 1u == (gen + 1u) * nloc) {
            __builtin_amdgcn_fence(__ATOMIC_RELEASE, "agent");
            asm volatile("s_waitcnt vmcnt(0)" ::: "memory");
            const unsigned og = xb_add(&bar[XB_TOP], 1u);
            const unsigned tg = og / nx;
            if (og + 1u == (tg + 1u) * nx) xb_add(&bar[XB_TOPGEN], 1u);
            else XB_SPIN(xb_ld(&bar[XB_TOPGEN]) == tg, bar);
            __builtin_amdgcn_fence(__ATOMIC_ACQUIRE, "agent");
            xb_add(&bar[XB_XGEN(b.x)], 1u);
            asm volatile("s_waitcnt vmcnt(0)" ::: "memory");
        } else {
            XB_SPIN(xb_ld(&bar[XB_XGEN(b.x)]) == gen, bar);
            __builtin_amdgcn_fence(__ATOMIC_ACQUIRE, "agent");
            asm volatile("s_waitcnt vmcnt(0)" ::: "memory");
        }
    }
    __syncthreads();
}

__device__ __forceinline__ void transpose_tile(const float* src, int N, bf16* dst, int ldt, LAS unsigned* scr, int lane) {
    const int q = lane & 15, kq = lane >> 4;
    f32x4 a[8], b[8];
#pragma unroll
    for (int r = 0; r < 8; ++r) { const int kp = kq + 4 * r; a[r] = *(const f32x4*)(src + (size_t)(2 * kp) * N + 4 * q); b[r] = *(const f32x4*)(src + (size_t)(2 * kp + 1) * N + 4 * q); }
#pragma unroll
    for (int r = 0; r < 8; ++r) { const int kp = kq + 4 * r; v4u w; w.x = pk2(a[r][0], b[r][0]); w.y = pk2(a[r][1], b[r][1]); w.z = pk2(a[r][2], b[r][2]); w.w = pk2(a[r][3], b[r][3]);
        *(LAS v4u*)(scr + kp * 68 + 4 * q) = w; }
    LDS_WAIT(); asm volatile("" ::: "memory");
    const int nn = lane & 7, c = lane >> 3;
#pragma unroll
    for (int j = 0; j < 8; ++j) { const int n = nn + 8 * j; const LAS unsigned* s = scr + (4 * c) * 68 + n;
        v4u o; o.x = s[0]; o.y = s[68]; o.z = s[136]; o.w = s[204];
        *(v4u*)(dst + (size_t)n * ldt + 8 * c) = o; }
    LDS_WAIT(); asm volatile("" ::: "memory");
}
constexpr int TI_IN = 16 * 68, TI_AO = 8 * 16, TI_CO = 8 * 16, TI_OUT = 16 * 16, TI_R = 16 * 4, TI_GS = 16 * 4, TI_US = 16 * 4, TI_DS = 4 * 16;
constexpr int TI_SMALL = TI_IN + TI_AO + TI_CO + TI_OUT + TI_R + TI_GS + TI_US + TI_DS;
constexpr int TI_E = 64 * NEXP;
constexpr int TI_TOTAL = TI_SMALL + 3 * TI_E;
__device__ __forceinline__ void transpose_item(const Args& A, int it, LAS unsigned* scr, int lane) {
    unsigned char* ws = A.ws;
    const float* W; int K, N; bf16* D; int rbase = 0, rstr = 128;
    int r = it;
    if (r < TI_IN) { W = A.w_in; K = 1024; N = IN_COLS; D = (bf16*)(ws + WS_WIN); }
    else if ((r -= TI_IN) < TI_AO) { W = A.w_attn_o; K = 512; N = 1024; D = (bf16*)(ws + WS_WAO); }
    else if ((r -= TI_AO) < TI_CO) { W = A.w_conv_o; K = 512; N = 1024; D = (bf16*)(ws + WS_WCO); }
    else if ((r -= TI_CO) < TI_OUT) { W = A.w_out; K = 1024; N = 1024; D = (bf16*)(ws + WS_WOUT); }
    else if ((r -= TI_OUT) < TI_R) { W = A.w_router; K = 1024; N = 256; D = (bf16*)(ws + WS_WRS); }
    else if ((r -= TI_R) < TI_GS) { W = A.w_gate_s; K = 1024; N = 256; D = (bf16*)(ws + WS_WRS); rbase = 256; rstr = 256; }
    else if ((r -= TI_GS) < TI_US) { W = A.w_up_s; K = 1024; N = 256; D = (bf16*)(ws + WS_WRS); rbase = 256 + 128; rstr = 256; }
    else if ((r -= TI_US) < TI_DS) { W = A.w_down_s; K = 256; N = 1024; D = (bf16*)(ws + WS_WSD); }
    else if ((r -= TI_DS) < TI_E) { const int e = r >> 6; r &= 63; W = A.w_gate_e + (size_t)e * 1024 * 256; K = 1024; N = 256; D = (bf16*)(ws + WS_WE1) + (size_t)e * 512 * 1024; rstr = 256; }
    else if ((r -= TI_E) < TI_E) { const int e = r >> 6; r &= 63; W = A.w_up_e + (size_t)e * 1024 * 256; K = 1024; N = 256; D = (bf16*)(ws + WS_WE1) + (size_t)e * 512 * 1024; rbase = 128; rstr = 256; }
    else { r -= TI_E; const int e = r >> 6; r &= 63; W = A.w_down_e + (size_t)e * 256 * 1024; K = 256; N = 1024; D = (bf16*)(ws + WS_WED) + (size_t)e * 1024 * 256; }
    const int ntn = N >> 6, kb = r / ntn, nb = r - kb * ntn, k0 = kb * 64, n0 = nb * 64;
    const int drow = rbase + (n0 >> 7) * rstr + (n0 & 127);
    transpose_tile(W + (size_t)k0 * N + n0, N, D + (size_t)drow * K + k0, K, scr, lane);
}
__device__ __forceinline__ void mod_item(const Args& A, int chunk, LAS unsigned char* lds, int tid, int wave, int lane) {
    LAS float* s = (LAS float*)lds;
    LAS float* red = (LAS float*)(lds + 65536);
    for (int i = tid; i < NB * DM; i += NWAVES * 64) { const float v = A.c[i]; s[i] = v / (1.0f + __expf(-v)); }
    __syncthreads();
    float acc[NB];
#pragma unroll
    for (int b = 0; b < NB; ++b) acc[b] = 0.f;
    const float* w = A.w_ada + (size_t)(wave * 128) * NMOD + chunk * 64 + lane;
#pragma unroll 2
    for (int k4 = 0; k4 < 128; k4 += 4) {
        float wv[4];
#pragma unroll
        for (int u = 0; u < 4; ++u) wv[u] = w[(size_t)(k4 + u) * NMOD];
#pragma unroll
        for (int b = 0; b < NB; ++b) { const f32x4 sv = *(const LAS f32x4*)(s + b * DM + wave * 128 + k4); acc[b] += sv[0] * wv[0]; acc[b] += sv[1] * wv[1]; acc[b] += sv[2] * wv[2]; acc[b] += sv[3] * wv[3]; }
    }
#pragma unroll
    for (int b = 0; b < NB; ++b) red[(wave * NB + b) * 64 + lane] = acc[b];
    __syncthreads();
    float* MOD = (float*)(A.ws + WS_MOD);
    for (int o = tid; o < NB * 64; o += NWAVES * 64) { const int b = o >> 6, cidx = o & 63; float v = 0.f;
#pragma unroll
        for (int wv = 0; wv < NWAVES; ++wv) v += red[(wv * NB + b) * 64 + cidx];
        MOD[(size_t)b * NMOD + chunk * 64 + cidx] = v + A.b_ada[chunk * 64 + cidx]; }
    __syncthreads();
}
__device__ __forceinline__ void norm_rows(const float* X, const float* g, const float* MOD, int sh_off, bf16* H, int gw, int ngw, int lane) {
    for (int m = gw; m < T; m += ngw) {
        const f32x4* xr = (const f32x4*)(X + (size_t)m * DM) + lane;
        f32x4 v[4]; float ss = 0.f;
#pragma unroll
        for (int j = 0; j < 4; ++j) { v[j] = xr[64 * j]; ss += (v[j][0] * v[j][0] + v[j][1] * v[j][1]) + (v[j][2] * v[j][2] + v[j][3] * v[j][3]); }
        const float rstd = rsqrtf(wave_sum(ss) * (1.0f / DM) + EPS);
        const float* mrow = MOD + (size_t)(m >> 11) * NMOD + sh_off;
        unsigned long long* o8 = (unsigned long long*)(H + (size_t)m * DM) + lane;
#pragma unroll
        for (int j = 0; j < 4; ++j) { const int col = 4 * lane + 256 * j;
            const f32x4 gg = *(const f32x4*)(g + col), sh = *(const f32x4*)(mrow + col), sc = *(const f32x4*)(mrow + DM + col);
            const f32x4 o = (v[j] * rstd) * gg * (sc + 1.0f) + sh;
            o8[64 * j] = (unsigned long long)pk2(o[0], o[1]) | ((unsigned long long)pk2(o[2], o[3]) << 32); }
    }
}
__device__ __forceinline__ void qk_post(const Args& A, int gtid, int ngt) {
    bf16* Q = (bf16*)(A.ws + WS_Q); bf16* Kb = (bf16*)(A.ws + WS_K);
    const float* TC = (const float*)(A.ws + WS_TBL); const float* TS = TC + 64 * 16;
    constexpr int NQ = T * 8, NK = T * 2;
    for (int p = gtid; p < NQ + NK; p += ngt) {
        const bool isq = p < NQ; bf16* ptr = isq ? Q + (size_t)p * 64 : Kb + (size_t)(p - NQ) * 64; const int t = isq ? (p >> 3) : ((p - NQ) >> 1);
        const float* g = isq ? A.qg : A.kg; const float scale = isq ? attn_body::C2 : 1.0f;
        float y[64];
        { const v4u* src = (const v4u*)ptr; float ss = 0.f;
#pragma unroll
          for (int i = 0; i < 8; ++i) { const v4u w = src[i];
              y[8 * i + 0] = pg8::bf_lo(w.x); y[8 * i + 1] = pg8::bf_hi(w.x); y[8 * i + 2] = pg8::bf_lo(w.y); y[8 * i + 3] = pg8::bf_hi(w.y);
              y[8 * i + 4] = pg8::bf_lo(w.z); y[8 * i + 5] = pg8::bf_hi(w.z); y[8 * i + 6] = pg8::bf_lo(w.w); y[8 * i + 7] = pg8::bf_hi(w.w); }
#pragma unroll
          for (int d = 0; d < 64; ++d) ss += y[d] * y[d];
          const float r = rsqrtf(ss * (1.0f / 64.0f) + EPS);
#pragma unroll
          for (int d = 0; d < 64; ++d) y[d] = y[d] * r * g[d]; }
        const int pr = (t & (SEQ - 1)) >> 6, pc = t & 63;
        float o[64];
#pragma unroll
        for (int d4 = 0; d4 < 4; ++d4) { const f32x4 cr = *(const f32x4*)(TC + pr * 16 + 4 * d4), sr = *(const f32x4*)(TS + pr * 16 + 4 * d4), cc = *(const f32x4*)(TC + pc * 16 + 4 * d4), sc = *(const f32x4*)(TS + pc * 16 + 4 * d4);
#pragma unroll
            for (int u = 0; u < 4; ++u) { const int d = 4 * d4 + u;
                o[d] = (y[d] * cr[u] - y[d + 16] * sr[u]) * scale; o[d + 16] = (y[d + 16] * cr[u] + y[d] * sr[u]) * scale;
                o[32 + d] = (y[32 + d] * cc[u] - y[48 + d] * sc[u]) * scale; o[48 + d] = (y[48 + d] * cc[u] + y[32 + d] * sc[u]) * scale; } }
        v4u* dst = (v4u*)ptr;
#pragma unroll
        for (int i = 0; i < 8; ++i) { v4u w; w.x = pk2(o[8 * i], o[8 * i + 1]); w.y = pk2(o[8 * i + 2], o[8 * i + 3]); w.z = pk2(o[8 * i + 4], o[8 * i + 5]); w.w = pk2(o[8 * i + 6], o[8 * i + 7]); dst[i] = w; }
    }
}
__device__ __forceinline__ void load8(const bf16* p, float (&f)[8]) { const v4u w = *(const v4u*)p;
    f[0] = pg8::bf_lo(w.x); f[1] = pg8::bf_hi(w.x); f[2] = pg8::bf_lo(w.y); f[3] = pg8::bf_hi(w.y); f[4] = pg8::bf_lo(w.z); f[5] = pg8::bf_hi(w.z); f[6] = pg8::bf_lo(w.w); f[7] = pg8::bf_hi(w.w); }
__device__ __forceinline__ void conv_rows(const Args& A, int gw, int ngw, int lane) {
    bf16* CB = (bf16*)(A.ws + WS_CB); const bf16* CC = (const bf16*)(A.ws + WS_CC); const bf16* CX = (const bf16*)(A.ws + WS_CX);
    const int c0 = 8 * lane;
    float w0[8], w1[8], w2[8];
#pragma unroll
    for (int i = 0; i < 8; ++i) { w0[i] = A.conv_w[c0 + i]; w1[i] = A.conv_w[512 + c0 + i]; w2[i] = A.conv_w[1024 + c0 + i]; }
    for (int m = gw; m < T; m += ngw) {
        const int t = m & (SEQ - 1); const size_t off = (size_t)m * 512 + c0;
        float a[8], b[8], pc[8], pp[8], pn[8], cb[8];
        load8(CC + off, a); load8(CX + off, b);
#pragma unroll
        for (int i = 0; i < 8; ++i) pc[i] = a[i] * b[i];
        if (t > 0) { load8(CC + off - 512, a); load8(CX + off - 512, b);
#pragma unroll
            for (int i = 0; i < 8; ++i) pp[i] = a[i] * b[i]; }
        else {
#pragma unroll
            for (int i = 0; i < 8; ++i) pp[i] = 0.f; }
        if (t < SEQ - 1) { load8(CC + off + 512, a); load8(CX + off + 512, b);
#pragma unroll
            for (int i = 0; i < 8; ++i) pn[i] = a[i] * b[i]; }
        else {
#pragma unroll
            for (int i = 0; i < 8; ++i) pn[i] = 0.f; }
        load8(CB + off, cb);
        float u[8];
#pragma unroll
        for (int i = 0; i < 8; ++i) u[i] = cb[i] * (w0[i] * pp[i] + w1[i] * pc[i] + w2[i] * pn[i]);
        v4u w; w.x = pk2(u[0], u[1]); w.y = pk2(u[2], u[3]); w.z = pk2(u[4], u[5]); w.w = pk2(u[6], u[7]);
        *(v4u*)(CB + off) = w;
    }
}
__device__ __forceinline__ unsigned ord_f32(float f) { const unsigned u = __float_as_uint(f); return (u & 0x80000000u) ? ~u : (u | 0x80000000u); }
__device__ __forceinline__ float unord_f32(unsigned k) { return __uint_as_float((k & 0x80000000u) ? (k & 0x7fffffffu) : ~k); }
typedef unsigned long long u64;
__device__ __forceinline__ u64 max64(u64 a, u64 b) { return a > b ? a : b; }
template <int MASK> __device__ __forceinline__ u64 swz_xor_64(u64 v) { return ((u64)swz_xor_u<MASK>((unsigned)(v >> 32)) << 32) | (u64)swz_xor_u<MASK>((unsigned)v); }
__device__ __forceinline__ u64 max_group8(u64 v) { v = max64(v, swz_xor_64<1>(v)); v = max64(v, swz_xor_64<2>(v)); v = max64(v, swz_xor_64<4>(v)); return v; }
__device__ __forceinline__ u64 max_wave(u64 v) { v = max_group8(v); v = max64(v, swz_xor_64<8>(v)); v = max64(v, swz_xor_64<16>(v));
    auto lo = __builtin_amdgcn_permlane32_swap((unsigned)v, (unsigned)v, false, false); auto hi = __builtin_amdgcn_permlane32_swap((unsigned)(v >> 32), (unsigned)(v >> 32), false, false);
    return max64(((u64)hi[0] << 32) | lo[0], ((u64)hi[1] << 32) | lo[1]); }
__device__ __forceinline__ void route_tokens(const Args& A, LAS unsigned char* misc, int tid, int wave, int lane) {
    LAS int* lhist = (LAS int*)(misc + L_HIST);
    const float* SC = (const float*)(A.ws + WS_SC);
    int* IDX = (int*)(A.ws + WS_IDX); float* WTS = (float*)(A.ws + WS_WTS); int* SLOT = (int*)(A.ws + WS_SLOT); int* HIST = (int*)(A.ws + WS_HIST);
    if (tid < NEXP) lhist[tid] = 0;
    __syncthreads();
    const f32x4 bias = *(const f32x4*)(A.r_bias + 4 * lane);
    for (int i = 0; i < 16; ++i) {
        const int t = blockIdx.x * 128 + wave * 16 + i;
        const f32x4 s = *(const f32x4*)(SC + (size_t)t * NEXP + 4 * lane);
        u64 key[4];
#pragma unroll
        for (int j = 0; j < 4; ++j) key[j] = ((u64)ord_f32(s[j] + bias[j]) << 32) | (u64)(255 - (4 * lane + j));
        u64 g1 = max64(max64(key[0], key[1]), max64(key[2], key[3]));
        g1 = max_group8(g1);
        u64 g2 = 0;
#pragma unroll
        for (int j = 0; j < 4; ++j) g2 = max64(g2, key[j] == g1 ? 0ull : key[j]);
        g2 = max_group8(g2);
        const float gscore = unord_f32((unsigned)(g1 >> 32)) + unord_f32((unsigned)(g2 >> 32));
        const int grp = lane >> 3; int rank = 0;
#pragma unroll
        for (int g = 0; g < 8; ++g) { const float og = bcast_f(gscore, 8 * g); rank += (og > gscore || (og == gscore && g < grp)) ? 1 : 0; }
        const bool sel = rank < 4;
#pragma unroll
        for (int j = 0; j < 4; ++j) if (!sel) key[j] = 0ull;
        int my_e = 0; float my_w = 0.f, wsum = 0.f;
#pragma unroll
        for (int k = 0; k < TOPK; ++k) {
            u64 w = max64(max64(key[0], key[1]), max64(key[2], key[3]));
            w = max_wave(w);
            const int e = 255 - (int)(unsigned)(w & 0xffffffffull);
            const int ej = e & 3; const float mine = ej == 0 ? s[0] : ej == 1 ? s[1] : ej == 2 ? s[2] : s[3];
            const float v = bcast_f(mine, __builtin_amdgcn_readfirstlane(e >> 2));
#pragma unroll
            for (int j = 0; j < 4; ++j) if (key[j] == w) key[j] = 0ull;
            wsum += v; if (lane == k) { my_e = e; my_w = v; }
        }
        if (lane < TOPK) {
            IDX[t * TOPK + lane] = my_e; WTS[t * TOPK + lane] = my_w / wsum * ROUTED_SCALE;
            SLOT[t * TOPK + lane] = atomicAdd((int*)&lhist[my_e], 1);
        }
    }
    __syncthreads();
    if (tid < NEXP) HIST[blockIdx.x * NEXP + tid] = lhist[tid];
}
__device__ __forceinline__ void assign_slots(const Args& A, LAS unsigned char* misc, int tid) {
    LAS int* l_pad = (LAS int*)(misc + L_PAD); LAS int* l_base = (LAS int*)(misc + L_BASE); LAS int* l_ps = (LAS int*)(misc + L_PS);
    const int* HIST = (const int*)(A.ws + WS_HIST); const int* IDX = (const int*)(A.ws + WS_IDX);
    int* SLOT = (int*)(A.ws + WS_SLOT); int* SLOT_TOK = (int*)(A.ws + WS_SLOT_TOK); int* TILE_E = (int*)(A.ws + WS_TILE_E); unsigned* CTL = (unsigned*)(A.ws + WS_CTL);
    if (tid < NEXP) { int cnt = 0, before = 0;
        for (int b = 0; b < (int)gridDim.x; ++b) { const int h = HIST[b * NEXP + tid]; cnt += h; before += (b < (int)blockIdx.x) ? h : 0; }
        l_pad[tid] = (cnt + 255) & ~255; l_base[tid] = before; }
    __syncthreads();
    if (tid == 0) { int run = 0; for (int e = 0; e < NEXP; ++e) { l_ps[e] = run; run += l_pad[e]; } l_ps[NEXP] = run; }
    __syncthreads();
    if (blockIdx.x == 0) {
        if (tid < NEXP) { const int t0 = l_ps[tid] >> 8, n = l_pad[tid] >> 8; for (int i = 0; i < n; ++i) TILE_E[t0 + i] = tid; }
        if (tid == 0) CTL[CW_NTILES] = (unsigned)(l_ps[NEXP] >> 8);
    }
    for (int a = tid; a < 128 * TOPK; a += NWAVES * 64) { const int j = blockIdx.x * 128 * TOPK + a; const int e = IDX[j];
        const int slot = l_ps[e] + l_base[e] + SLOT[j]; SLOT[j] = slot; SLOT_TOK[slot] = j >> 3; }
}
__device__ __forceinline__ void combine_rows(const Args& A, int gw, int ngw, int lane) {
    const bf16* Y = (const bf16*)(A.ws + WS_Y); const int* SLOT = (const int*)(A.ws + WS_SLOT); const float* WTS = (const float*)(A.ws + WS_WTS);
    const float* MOD = (const float*)(A.ws + WS_MOD);
    for (int m = gw; m < T; m += ngw) {
        int sl = 0; float wt = 0.f;
        if (lane < TOPK) { sl = SLOT[m * TOPK + lane]; wt = WTS[m * TOPK + lane]; }
        float acc[16];
#pragma unroll
        for (int i = 0; i < 16; ++i) acc[i] = 0.f;
#pragma unroll
        for (int k = 0; k < TOPK; ++k) { const int s = __builtin_amdgcn_readlane(sl, k); const float w = bcast_f(wt, k); const bf16* yr = Y + (size_t)s * DM + 8 * lane;
            float f0[8], f1[8]; load8(yr, f0); load8(yr + 512, f1);
#pragma unroll
            for (int i = 0; i < 8; ++i) { acc[i] += w * f0[i]; acc[8 + i] += w * f1[i]; } }
        const float* gt = MOD + (size_t)(m >> 11) * NMOD + 5 * DM + 8 * lane;
        float* o = A.out + (size_t)m * DM + 8 * lane;
#pragma unroll
        for (int h = 0; h < 2; ++h)
#pragma unroll
            for (int q = 0; q < 2; ++q) { const f32x4 g4 = *(const f32x4*)(gt + 512 * h + 4 * q), x4 = *(const f32x4*)(o + 512 * h + 4 * q);
                const f32x4 a4 = (f32x4){acc[8 * h + 4 * q], acc[8 * h + 4 * q + 1], acc[8 * h + 4 * q + 2], acc[8 * h + 4 * q + 3]};
                *(f32x4*)(o + 512 * h + 4 * q) = x4 + g4 * a4; }
    }
}

__global__ void __launch_bounds__(NWAVES * 64, 2) fwd_megakernel(Args Araw) {
    extern __shared__ __attribute__((aligned(16))) unsigned char lds_raw[];
    typedef const __attribute__((address_space(4))) Args* CArgs;
    cg::grid_group grid = cg::this_grid();
    LAS unsigned char* lds = (LAS unsigned char*)lds_raw;
    LAS unsigned char* misc = lds + MISC_OFF;
    const int wave_s = __builtin_amdgcn_readfirstlane((int)threadIdx.x >> 6);
#define LANE_ID() ({ unsigned z_ = 0u; asm volatile("" : "+v"(z_)); (int)__builtin_amdgcn_mbcnt_hi(~0u, __builtin_amdgcn_mbcnt_lo(~0u, z_)); })
    XcdBarrier xbar;
    { const int tid0 = wave_s * 64 + LANE_ID();
      volatile LAS unsigned* st = (volatile LAS unsigned*)(misc + L_BARST);
      if (tid0 < 2) st[tid0] = 0u;
      __syncthreads();
      CArgs ap0 = (CArgs)__builtin_amdgcn_kernarg_segment_ptr(); unsigned char* ws0 = ap0->ws;
      xbar = xcd_barrier_post((unsigned*)(ws0 + WS_CTL) + CW_BAR, st, tid0); }
#if defined(__HIP_DEVICE_COMPILE__)
#define PHASE_ARGS CArgs ap_ = (CArgs)__builtin_amdgcn_kernarg_segment_ptr(); asm volatile("" : "+s"(ap_)); const Args A = *ap_; unsigned char* const ws = A.ws; float* const MOD = (float*)(ws + WS_MOD); (void)MOD;
#else
#define PHASE_ARGS const Args A = Araw; unsigned char* const ws = A.ws; float* const MOD = (float*)(ws + WS_MOD); (void)MOD;
#endif
#define PHASE_IDS const int wave = wave_s; int tid = wave_s * 64 + LANE_ID(); asm volatile("" : "+v"(tid)); const int lane = tid & 63; \
    int G = gridDim.x, bx = blockIdx.x; asm volatile("" : "+s"(G), "+s"(bx)); const int vcu = (G % 8 == 0) ? (bx % 8) * (G / 8) + bx / 8 : bx; const int gw = vcu * NWAVES + wave, ngw = G * NWAVES; \
    (void)lane; (void)gw; (void)ngw;
#define GRID_SYNC() do { const int tb_ = wave_s * 64 + LANE_ID(); xcd_barrier(xbar, tb_); } while (0)
#define PH(n) ((PHMASK >> (n)) & 1)

    if (PH(0)) { PHASE_ARGS PHASE_IDS
        if (bx < NMOD / 64) mod_item(A, bx, lds, tid, wave, lane);
        { LAS unsigned* scr = (LAS unsigned*)(lds + wave * 8704);
          for (int it = gw; it < TI_TOTAL; it += ngw) transpose_item(A, it, scr, lane); }
        { float* TC = (float*)(ws + WS_TBL); float* TS = TC + 64 * 16;
          const int gt_ = bx * NWAVES * 64 + tid;
          if (gt_ < 64 * 16) { const int pos = gt_ >> 4, i = gt_ & 15; const float inv = powf(10000.0f, -(float)(2 * i) / 32.0f); const float ang = (float)pos * inv; TC[gt_] = cosf(ang); TS[gt_] = sinf(ang); }
          int* SLOT_TOK = (int*)(ws + WS_SLOT_TOK);
          for (int i = gt_; i < NSLOT_MAX; i += G * NWAVES * 64) SLOT_TOK[i] = 0; }
    }
    GRID_SYNC();
    if (PH(1)) { PHASE_ARGS PHASE_IDS
        norm_rows(A.x, A.g_mix, MOD, 0, (bf16*)(ws + WS_H), gw, ngw, lane);
    }
    GRID_SYNC();
    if (PH(2)) { PHASE_ARGS PHASE_IDS
        pg8::Gemm g{(const bf16*)(ws + WS_H), (const bf16*)(ws + WS_WIN), DM, DM, nullptr}; pg8::StaticOrder S; S.init(T, IN_COLS, G, bx);
        pg8::EpiProj E{(bf16*)(ws + WS_Q), (bf16*)(ws + WS_K), (bf16*)(ws + WS_V), (bf16*)(ws + WS_CB), (bf16*)(ws + WS_CC), (bf16*)(ws + WS_CX), (bf16*)(ws + WS_SGA), (bf16*)(ws + WS_SGC)};
        pg8::gemm_phase<pg8::EpiProj, pg8::StaticOrder, false>(lds, g, S, E, tid);
    }
    GRID_SYNC();
    if (PH(3)) { PHASE_ARGS PHASE_IDS
        qk_post(A, bx * NWAVES * 64 + tid, G * NWAVES * 64);
        conv_rows(A, gw, ngw, lane);
    }
    GRID_SYNC();
    if (PH(4)) { PHASE_ARGS PHASE_IDS
        const attn_body::AttnTensors AT{(const attn_body::bf16*)(ws + WS_Q), (const attn_body::bf16*)(ws + WS_K), (const attn_body::bf16*)(ws + WS_V), (attn_body::bf16*)(ws + WS_O)};
        const attn_body::StaticOrder S(G, bx);
        attn_body::attn_phase<attn_body::StaticOrder>((char*)lds_raw, AT, S, tid);
    }
    GRID_SYNC();
    if (PH(5)) {
        { PHASE_ARGS PHASE_IDS pg8::StaticOrder S; S.init(T, DM, G, bx); pg8::Gemm g{(const bf16*)(ws + WS_O), (const bf16*)(ws + WS_WAO), 512, 512, nullptr}; pg8::EpiGate<false> E{(const bf16*)(ws + WS_SGA), (bf16*)(ws + WS_MG)};
          pg8::gemm_phase<pg8::EpiGate<false>, pg8::StaticOrder, false>(lds, g, S, E, tid); }
        { PHASE_ARGS PHASE_IDS pg8::StaticOrder S; S.init(T, DM, G, bx); pg8::Gemm g{(const bf16*)(ws + WS_CB), (const bf16*)(ws + WS_WCO), 512, 512, nullptr}; pg8::EpiGate<true> E{(const bf16*)(ws + WS_SGC), (bf16*)(ws + WS_MG)};
          pg8::gemm_phase<pg8::EpiGate<true>, pg8::StaticOrder, false>(lds, g, S, E, tid); }
    }
    GRID_SYNC();
    if (PH(6)) { PHASE_ARGS PHASE_IDS
        pg8::Gemm g{(const bf16*)(ws + WS_MG), (const bf16*)(ws + WS_WOUT), DM, DM, nullptr}; pg8::StaticOrder S; S.init(T, DM, G, bx);
        pg8::EpiResid<false> E{A.x, A.out, MOD + 2 * DM};
        pg8::gemm_phase<pg8::EpiResid<false>, pg8::StaticOrder, false>(lds, g, S, E, tid);
    }
    GRID_SYNC();
    if (PH(7)) { PHASE_ARGS PHASE_IDS
        norm_rows(A.out, A.g_ffn, MOD, 3 * DM, (bf16*)(ws + WS_H), gw, ngw, lane);
    }
    GRID_SYNC();
    if (PH(8)) { PHASE_ARGS PHASE_IDS
        pg8::Gemm g{(const bf16*)(ws + WS_H), (const bf16*)(ws + WS_WRS), DM, DM, nullptr}; pg8::StaticOrder S; S.init(T, 768, G, bx);
        pg8::EpiRouterShared E{(float*)(ws + WS_SC), (bf16*)(ws + WS_HS)};
        pg8::gemm_phase<pg8::EpiRouterShared, pg8::StaticOrder, false>(lds, g, S, E, tid);
    }
    GRID_SYNC();
    if (PH(9)) {
        { PHASE_ARGS PHASE_IDS route_tokens(A, misc, tid, wave, lane); }
        { PHASE_ARGS PHASE_IDS pg8::Gemm g{(const bf16*)(ws + WS_HS), (const bf16*)(ws + WS_WSD), EFF, EFF, nullptr}; pg8::StaticOrder S; S.init(T, DM, G, bx);
          pg8::EpiResid<true> E{A.out, A.out, MOD + 5 * DM};
          pg8::gemm_phase<pg8::EpiResid<true>, pg8::StaticOrder, false>(lds, g, S, E, tid); }
    }
    GRID_SYNC();
    if (PH(10)) { PHASE_ARGS PHASE_IDS
        assign_slots(A, misc, tid);
    }
    GRID_SYNC();
    if (PH(11)) { PHASE_ARGS PHASE_IDS
        const int ntiles = (int)__hip_atomic_load((unsigned*)(ws + WS_CTL) + CW_NTILES, __ATOMIC_RELAXED, __HIP_MEMORY_SCOPE_AGENT);
        LAS int* tileE = (LAS int*)(misc + L_TILEE);
        { const int* TILE_E = (const int*)(ws + WS_TILE_E); for (int i = tid; i < ntiles; i += NWAVES * 64) tileE[i] = TILE_E[i]; }
        __syncthreads();
        pg8::Gemm g{(const bf16*)(ws + WS_H), (const bf16*)(ws + WS_WE1), DM, DM, (const int*)(ws + WS_SLOT_TOK)};
        pg8::DynOrder S{ntiles * 2, G, bx, 2, tileE};
        pg8::EpiExpert1 E{(bf16*)(ws + WS_HID)};
        pg8::gemm_phase<pg8::EpiExpert1, pg8::DynOrder, true>(lds, g, S, E, tid);
    }
    GRID_SYNC();
    if (PH(12)) { PHASE_ARGS PHASE_IDS
        const int ntiles = (int)__hip_atomic_load((unsigned*)(ws + WS_CTL) + CW_NTILES, __ATOMIC_RELAXED, __HIP_MEMORY_SCOPE_AGENT);
        LAS int* tileE = (LAS int*)(misc + L_TILEE);
        { const int* TILE_E = (const int*)(ws + WS_TILE_E); for (int i = tid; i < ntiles; i += NWAVES * 64) tileE[i] = TILE_E[i]; }
        __syncthreads();
        pg8::Gemm g{(const bf16*)(ws + WS_HID), (const bf16*)(ws + WS_WED), EFF, EFF, nullptr};
        pg8::DynOrder S{ntiles * 4, G, bx, 4, tileE};
        pg8::EpiExpert2 E{(bf16*)(ws + WS_Y)};
        pg8::gemm_phase<pg8::EpiExpert2, pg8::DynOrder, false>(lds, g, S, E, tid);
    }
    GRID_SYNC();
    if (PH(13)) { PHASE_ARGS PHASE_IDS
        combine_rows(A, gw, ngw, lane);
    }
}

extern "C" void kernel_launch(void* const* d_in, const int* in_sizes, int n_in, void* d_out, int out_size, void* d_ws, size_t ws_size, hipStream_t stream) {
    static int grid = 0;
    if (grid == 0) {
        if (n_in != 21 || in_sizes[0] != T * DM || out_size != T * DM || ws_size < WS_END) { fprintf(stderr, "kernel_launch: unexpected problem shape or workspace (%zu < %zu); nothing launched\n", ws_size, (size_t)WS_END); grid = -1; return; }
        int dev = 0, cus = 0, per_cu = 0;
        if (hipGetDevice(&dev) != hipSuccess || hipDeviceGetAttribute(&cus, hipDeviceAttributeMultiprocessorCount, dev) != hipSuccess) { grid = -1; return; }
        if (hipFuncSetAttribute((const void*)fwd_megakernel, hipFuncAttributeMaxDynamicSharedMemorySize, LDS_BYTES) != hipSuccess) { fprintf(stderr, "kernel_launch: hipFuncSetAttribute failed\n"); grid = -1; return; }
        if (hipOccupancyMaxActiveBlocksPerMultiprocessor(&per_cu, (const void*)fwd_megakernel, NWAVES * 64, LDS_BYTES) != hipSuccess || per_cu < 1) { fprintf(stderr, "kernel_launch: occupancy query says %d blocks per CU\n", per_cu); (void)hipGetLastError(); grid = -1; return; }
        grid = cus;
        if (grid != 256) { fprintf(stderr, "kernel_launch: built for a 256-CU device, found %d CUs; nothing launched\n", cus); grid = -1; return; }
    }
    if (grid < 0) return;
    if (hipMemsetAsync((char*)d_ws + WS_CTL, 0, CTL_ZERO_BYTES, stream) != hipSuccess) { fprintf(stderr, "kernel_launch: hipMemsetAsync failed\n"); return; }
    Args a{};
    const float** p = (const float**)&a;
    for (int i = 0; i < 21; ++i) p[i] = (const float*)d_in[i];
    a.out = (float*)d_out; a.ws = (unsigned char*)d_ws;
    void* args[] = {&a};
    const hipError_t e = hipLaunchCooperativeKernel((const void*)fwd_megakernel, dim3(grid), dim3(NWAVES * 64), args, LDS_BYTES, stream);
    if (e != hipSuccess) fprintf(stderr, "kernel_launch: cooperative launch failed: %s (grid %d)\n", hipGetErrorString(e), grid);
}
```

```cpp
#include <hip/hip_runtime.h>
#include <hip/hip_cooperative_groups.h>
#include <hip/hip_bf16.h>
#include <cstdio>
#include <cstdint>
#include <cmath>
namespace cg = cooperative_groups;
#ifndef PHMASK
#define PHMASK 0x3fff
#endif

namespace pg8 {
#define PG8_LAS __attribute__((address_space(3)))
typedef unsigned short bf16_t;
typedef short bf16x8 __attribute__((ext_vector_type(8)));
typedef float f32x4 __attribute__((ext_vector_type(4)));
typedef unsigned u32x4 __attribute__((ext_vector_type(4)));
constexpr int BM = 256, BK = 64, HALF = 128, HTB = HALF * BK * 2  , STAGE_BYTES = 8 * HTB, NXCD = 8, WGM = 8;

__host__ __device__ __forceinline__ int lds_byte(int r, int c) { const int st = (r >> 4) * 2 + (c >> 5), rr = r & 15, cc = c & 31, ob = rr * 64 + cc * 2; return st * 1024 + (ob ^ (((ob >> 9) & 1) << 5)); }
__host__ __device__ __forceinline__ void stage_rc(int b, int& R, int& C) { const int st = b / 1024, sb = b % 1024, swz = sb ^ (((sb >> 9) & 1) << 5); R = (st >> 1) * 16 + swz / 64; C = (st & 1) * 32 + (swz % 64) / 2; }
__host__ __device__ __forceinline__ int perm32(int rho) { const int n = rho >> 4, i = rho & 15; return 8 * (i >> 2) + 4 * n + (i & 3); }

struct Unit { int pm, pn, pnb, aux; };
struct Gemm { const bf16_t* A; const bf16_t* Bt; int lda, K; const int* rowidx; };

struct StaticOrder {
    int nM, nN, nwg, G, c;
    __host__ __device__ void init(int M, int N, int G_, int c_) { nM = M / BM; nN = N / BM; nwg = nM * nN; G = G_; c = c_; }
    __host__ __device__ bool next(int i, Unit& u) const {
        const long L = (long)i * G + c; if (L >= nwg) return false;
        int wgid = (int)L; { const int q = nwg / NXCD, r = nwg % NXCD, xcd = wgid % NXCD, off = wgid / NXCD; wgid = (xcd < r ? xcd * (q + 1) : r * (q + 1) + (xcd - r) * q) + off; }
        const int nig = WGM * nN, gid = wgid / nig, fm = gid * WGM, gsz = (nM - fm) < WGM ? (nM - fm) : WGM;
        u.pm = fm + ((wgid % nig) % gsz); u.pn = (wgid % nig) / gsz; u.pnb = u.pn; u.aux = 0; return true;
    }
};
struct DynOrder {
    int nunits, G, c, NPN; const PG8_LAS int* tileE;
    __device__ __forceinline__ bool next(int i, Unit& u) const {
        const long L = (long)i * G + c; if (L >= nunits) return false;
        int id = (int)L; { const int q = nunits / NXCD, r = nunits % NXCD, xcd = id % NXCD, off = id / NXCD; id = (xcd < r ? xcd * (q + 1) : r * (q + 1) + (xcd - r) * q) + off; }
        const int tile = id / NPN, pn = id - tile * NPN; const int e = tileE[tile];
        u.pm = tile; u.pn = pn; u.pnb = e * NPN + pn; u.aux = e; return true;
    }
};

__device__ __forceinline__ unsigned cvt_pk_bf16(float lo, float hi) { unsigned r; asm volatile("v_cvt_pk_bf16_f32 %0, %1, %2" : "=v"(r) : "v"(lo), "v"(hi)); return r; }
__device__ __forceinline__ float bf_lo(unsigned w) { return __uint_as_float(w << 16); }
__device__ __forceinline__ float bf_hi(unsigned w) { return __uint_as_float(w & 0xffff0000u); }
__device__ __forceinline__ float sigmoid_f(float v) { return __builtin_amdgcn_rcpf(1.0f + __builtin_amdgcn_exp2f(-1.4426950408889634f * v)); }

template <class Epi, class Sched, bool GATHER>
__device__ __forceinline__ void gemm_phase(PG8_LAS unsigned char* lds, const Gemm g, const Sched& S, const Epi& E, int tid) {
    asm volatile("" : "+v"(tid));
    const int wid = __builtin_amdgcn_readfirstlane(tid >> 6), lane = tid & 63, wr = wid >> 2, wc = wid & 3, fr = lane & 15, fq = lane >> 4;
    int K_ = g.K; asm volatile("" : "+s"(K_));
    const int K = K_, nt = K / BK;
    const unsigned lda2 = (unsigned)g.lda * 2u;
    unsigned voffA[2], voffB[2];
#pragma unroll
    for (int i = 0; i < 2; ++i) { int R, C; stage_rc(tid * 16 + i * 8192, R, C); const int Rb = (R & ~31) + perm32(R & 31);
        voffA[i] = GATHER ? 0u : (unsigned)R * lda2 + (unsigned)C * 2u; voffB[i] = (unsigned)(Rb * K + C) * 2u; }
    const size_t hstepA = (size_t)HALF * lda2, tstepA = 2 * hstepA;
    const size_t kstep = (size_t)(BK * 2);
    const size_t hstepB = (size_t)HALF * K * 2;
    const size_t tstepB = 2 * hstepB;
    const unsigned ldsw = (unsigned)wid * 1024u;
    const int aoff = lds_byte(wr * 64 + fr, fq * 8), boff = lds_byte(wc * 32 + fr, fq * 8);
#define PG8_SA(b, h) (((b) * 2 + (h)) * HTB)
#define PG8_SB(b, h) ((4 + (b) * 2 + (h)) * HTB)
#define PG8_STAGE2(bufoff, gbase, o0, o1) do { \
        __builtin_amdgcn_global_load_lds((const unsigned*)((const char*)(gbase) + (o0)), (PG8_LAS unsigned*)(lds + (bufoff) + ldsw), 16, 0, 0); \
        __builtin_amdgcn_global_load_lds((const unsigned*)((const char*)(gbase) + (o1)), (PG8_LAS unsigned*)(lds + (bufoff) + ldsw + 8192), 16, 0, 0); } while (0)
#define PG8_STAGEB(bufoff, gbase) PG8_STAGE2(bufoff, gbase, voffB[0], voffB[1])
#define PG8_AOFF(dst, u) do { if constexpr (GATHER) { _Pragma("unroll") for (int i_ = 0; i_ < 2; ++i_) { int R_, C_; stage_rc(tid * 16 + i_ * 8192, R_, C_); _Pragma("unroll") for (int h_ = 0; h_ < 2; ++h_) \
        dst[h_][i_] = (unsigned)g.rowidx[(u).pm * BM + h_ * HALF + R_] * lda2 + (unsigned)C_ * 2u; } } } while (0)
#define PG8_STAGEA(bufoff, ptr, h, nx) do { if constexpr (GATHER) { const unsigned o0_ = (nx) ? na[h][0] : ca[h][0], o1_ = (nx) ? na[h][1] : ca[h][1]; PG8_STAGE2(bufoff, ptr, o0_, o1_); } \
        else { PG8_STAGE2(bufoff, (ptr) + (h) * hstepA, voffA[0], voffA[1]); } } while (0)
#define PG8_LDA(dst, b, h) do { _Pragma("unroll") for (int m = 0; m < 4; ++m) _Pragma("unroll") for (int k = 0; k < 2; ++k) dst[m][k] = *(const PG8_LAS bf16x8*)(lds + PG8_SA(b, h) + aoff + m * 2048 + k * 1024); } while (0)
#define PG8_LDB(dst, b, h) do { _Pragma("unroll") for (int n = 0; n < 2; ++n) _Pragma("unroll") for (int k = 0; k < 2; ++k) dst[n][k] = *(const PG8_LAS bf16x8*)(lds + PG8_SB(b, h) + boff + n * 2048 + k * 1024); } while (0)
#define PG8_MMA(ai, bj, At, Bt) do { __builtin_amdgcn_s_setprio(1); _Pragma("unroll") for (int m = 0; m < 4; ++m) _Pragma("unroll") for (int n = 0; n < 2; ++n) _Pragma("unroll") for (int k = 0; k < 2; ++k) \
        acc[ai][bj][m][n] = __builtin_amdgcn_mfma_f32_16x16x32_bf16(Bt[n][k], At[m][k], acc[ai][bj][m][n], 0, 0, 0); __builtin_amdgcn_s_setprio(0); } while (0)
#define PG8_WAIT_V(n) asm volatile("s_waitcnt vmcnt(" #n ")" ::: "memory")
#define PG8_WAIT_V8R() do { if (relax > 0) { asm volatile("s_waitcnt vmcnt(%0)" :: "n"(8 + Epi::NSTORE) : "memory"); --relax; } else { asm volatile("s_waitcnt vmcnt(8)" ::: "memory"); } } while (0)
#define PG8_WAIT_L(n) asm volatile("s_waitcnt lgkmcnt(" #n ")" ::: "memory")
#define PG8_BAR __builtin_amdgcn_s_barrier()
#define PG8_SCHED __builtin_amdgcn_sched_barrier(0)
    Unit cur, nxt; int ui = 0; int relax = 0; static_assert(8 + Epi::NSTORE <= 63, "vmcnt is a 6-bit count");
    if (!S.next(0, cur)) return;
    f32x4 acc[2][2][4][2];
#pragma unroll
    for (int a = 0; a < 2; ++a)
#pragma unroll
        for (int b = 0; b < 2; ++b)
#pragma unroll
            for (int m = 0; m < 4; ++m)
#pragma unroll
                for (int n = 0; n < 2; ++n) acc[a][b][m][n] = (f32x4){0.f, 0.f, 0.f, 0.f};
    bf16x8 At[4][2], B0[2][2], B1[2][2];
    unsigned ca[2][2], na[2][2];
    PG8_AOFF(ca, cur);
    const char* cA = (const char*)g.A + (GATHER ? (size_t)0 : (size_t)cur.pm * tstepA);
    const char* cB = (const char*)g.Bt + (size_t)cur.pnb * tstepB;
    PG8_STAGEB(PG8_SB(0, 0), cB); PG8_STAGEB(PG8_SB(0, 1), cB + hstepB); PG8_STAGEA(PG8_SA(0, 0), cA, 0, false); PG8_STAGEA(PG8_SA(0, 1), cA, 1, false);
    if (wr == 1) PG8_BAR;
    PG8_WAIT_V(2); PG8_BAR;
    PG8_STAGEB(PG8_SB(1, 0), cB + kstep); PG8_STAGEA(PG8_SA(1, 0), cA + kstep, 0, false); PG8_STAGEB(PG8_SB(1, 1), cB + hstepB + kstep);
    PG8_WAIT_V(6); PG8_BAR;
    for (;;) {
        const bool has_next = S.next(ui + 1, nxt);
        const char* nB = has_next ? (const char*)g.Bt + (size_t)nxt.pnb * tstepB : cB;
        const char* nA = (has_next && !GATHER) ? (const char*)g.A + (size_t)nxt.pm * tstepA : cA;
        if constexpr (GATHER) { if (has_next) { PG8_AOFF(na, nxt); } else { na[0][0] = ca[0][0]; na[0][1] = ca[0][1]; na[1][0] = ca[1][0]; na[1][1] = ca[1][1]; } }
#pragma unroll 1
        for (int t = 0; t < nt; t += 2) {
            const bool last = (t == nt - 2);
            const char* a1 = cA + (size_t)(t + 1) * kstep;
            const char* a2 = last ? nA : cA + (size_t)(t + 2) * kstep; const char* b2 = last ? nB : cB + (size_t)(t + 2) * kstep;
            const char* a3 = a2 + kstep; const char* b3 = b2 + kstep;
            PG8_LDB(B0, 0, 0); PG8_LDB(B1, 0, 1); PG8_SCHED; PG8_LDA(At, 0, 0); PG8_STAGEA(PG8_SA(1, 1), a1, 1, false);
            PG8_WAIT_V8R(); PG8_WAIT_L(0); PG8_BAR; PG8_MMA(0, 0, At, B0); PG8_MMA(0, 1, At, B1); PG8_BAR; PG8_SCHED;
            PG8_LDA(At, 0, 1); PG8_STAGEB(PG8_SB(0, 0), b2); PG8_STAGEB(PG8_SB(0, 1), b2 + hstepB); PG8_STAGEA(PG8_SA(0, 0), a2, 0, last);
            PG8_WAIT_V8R(); PG8_WAIT_L(0); PG8_BAR; PG8_MMA(1, 0, At, B0); PG8_MMA(1, 1, At, B1); PG8_BAR; PG8_SCHED;
            PG8_LDB(B0, 1, 0); PG8_LDB(B1, 1, 1); PG8_SCHED; PG8_LDA(At, 1, 0); PG8_STAGEA(PG8_SA(0, 1), a2, 1, last);
            PG8_WAIT_V8R(); PG8_WAIT_L(0); PG8_BAR; PG8_MMA(0, 0, At, B0); PG8_MMA(0, 1, At, B1); PG8_BAR; PG8_SCHED;
            PG8_LDA(At, 1, 1); PG8_STAGEB(PG8_SB(1, 0), b3); PG8_STAGEB(PG8_SB(1, 1), b3 + hstepB); PG8_STAGEA(PG8_SA(1, 0), a3, 0, last);
            PG8_WAIT_V8R(); PG8_WAIT_L(0); PG8_BAR; PG8_MMA(1, 0, At, B0); PG8_MMA(1, 1, At, B1); PG8_BAR; PG8_SCHED;
        }
        if (wr == 0) PG8_BAR;
        E(acc, cur, wr, wc, fr, fq);
        if (!has_next) break;
        relax = 2;
#pragma unroll
        for (int a = 0; a < 2; ++a)
#pragma unroll
            for (int b = 0; b < 2; ++b)
#pragma unroll
                for (int m = 0; m < 4; ++m)
#pragma unroll
                    for (int n = 0; n < 2; ++n) acc[a][b][m][n] = (f32x4){0.f, 0.f, 0.f, 0.f};
        cur = nxt; cA = nA; cB = nB; ++ui;
        if constexpr (GATHER) { ca[0][0] = na[0][0]; ca[0][1] = na[0][1]; ca[1][0] = na[1][0]; ca[1][1] = na[1][1]; }
        if (wr == 1) PG8_BAR;
    }
    PG8_WAIT_V(0);
    PG8_BAR;
#undef PG8_SA
#undef PG8_SB
#undef PG8_STAGE2
#undef PG8_STAGEB
#undef PG8_AOFF
#undef PG8_STAGEA
#undef PG8_LDA
#undef PG8_LDB
#undef PG8_MMA
#undef PG8_WAIT_V
#undef PG8_WAIT_V8R
#undef PG8_WAIT_L
#undef PG8_BAR
#undef PG8_SCHED
}
typedef const f32x4 (&AccRef)[2][2][4][2];
__device__ __forceinline__ u32x4 pack8(f32x4 v0, f32x4 v1) { u32x4 w; w.x = cvt_pk_bf16(v0[0], v0[1]); w.y = cvt_pk_bf16(v0[2], v0[3]); w.z = cvt_pk_bf16(v1[0], v1[1]); w.w = cvt_pk_bf16(v1[2], v1[3]); return w; }
__device__ __forceinline__ void unpack8(u32x4 w, f32x4& v0, f32x4& v1) { v0 = (f32x4){bf_lo(w.x), bf_hi(w.x), bf_lo(w.y), bf_hi(w.y)}; v1 = (f32x4){bf_lo(w.z), bf_hi(w.z), bf_lo(w.w), bf_hi(w.w)}; }
__device__ __forceinline__ f32x4 sig4(f32x4 v) { return (f32x4){sigmoid_f(v[0]), sigmoid_f(v[1]), sigmoid_f(v[2]), sigmoid_f(v[3])}; }

struct EpiProj {
    static constexpr int NSTORE = 16;
    unsigned char* ws; size_t oQ, oK, oV, oCB, oCC, oCX, oSGA, oSGC;
    __device__ __forceinline__ void operator()(AccRef acc, const Unit& u, int wr, int wc, int fr, int fq) const {
        const int pn = u.pn; const int row0 = u.pm * BM + wr * 64 + fr;
#pragma unroll
        for (int bj = 0; bj < 2; ++bj) {
            size_t bo; int ld, c0; bool act = false;
            if (pn < 2)       { bo = oQ;  ld = 512; c0 = pn * 256 + bj * HALF; }
            else if (pn == 2) { bo = bj == 0 ? oK : oV; ld = 128; c0 = 0; }
            else if (pn < 5)  { bo = oCB; ld = 512; c0 = (pn - 3) * 256 + bj * HALF; }
            else if (pn < 7)  { bo = oCC; ld = 512; c0 = (pn - 5) * 256 + bj * HALF; }
            else if (pn < 9)  { bo = oCX; ld = 512; c0 = (pn - 7) * 256 + bj * HALF; }
            else if (pn < 13) { bo = oSGA; ld = 1024; c0 = (pn - 9) * 256 + bj * HALF; act = true; }
            else              { bo = oSGC; ld = 1024; c0 = (pn - 13) * 256 + bj * HALF; act = true; }
            bf16_t* base = (bf16_t*)(ws + bo);
            const int col = c0 + wc * 32 + 8 * fq;
#pragma unroll
            for (int ai = 0; ai < 2; ++ai)
#pragma unroll
                for (int m = 0; m < 4; ++m) { f32x4 v0 = acc[ai][bj][m][0], v1 = acc[ai][bj][m][1];
                    if (act) { v0 = sig4(v0); v1 = sig4(v1); }
                    *(u32x4*)(base + (size_t)(row0 + ai * HALF + m * 16) * ld + col) = pack8(v0, v1); }
        }
    }
};
#define PG8_ITEM(idx, ai, m, bj) const int ai = (idx) >> 3, m = ((idx) >> 1) & 3, bj = (idx) & 1
#define PG8_MEMFENCE() asm volatile("" ::: "memory")
template <bool ADD> struct EpiGate {
    static constexpr int NSTORE = 16;
    const bf16_t* SG; bf16_t* MG;
    __device__ __forceinline__ void operator()(AccRef acc, const Unit& u, int wr, int wc, int fr, int fq) const {
        const int row0 = u.pm * BM + wr * 64 + fr, col0 = u.pn * BM + wc * 32 + 8 * fq;
        u32x4 sg[2][4], mg[2][4];
#define PG8_OFF(idx) ({ PG8_ITEM(idx, ai_, m_, bj_); (size_t)(row0 + ai_ * HALF + m_ * 16) * 1024 + col0 + bj_ * HALF; })
#define PG8_ISSUE(g) do { _Pragma("unroll") for (int i_ = 0; i_ < 4; ++i_) { const size_t off_ = PG8_OFF(4 * (g) + i_); sg[(g) & 1][i_] = *(const u32x4*)(SG + off_); if (ADD) mg[(g) & 1][i_] = *(const u32x4*)(MG + off_); } } while (0)
        PG8_ISSUE(0); PG8_MEMFENCE();
#pragma unroll
        for (int g = 0; g < 4; ++g) {
            if (g < 3) PG8_ISSUE(g + 1);
            PG8_MEMFENCE();
#pragma unroll
            for (int i = 0; i < 4; ++i) { PG8_ITEM(4 * g + i, ai, m, bj); const size_t off = PG8_OFF(4 * g + i);
                f32x4 g0, g1; unpack8(sg[g & 1][i], g0, g1);
                f32x4 v0 = g0 * acc[ai][bj][m][0], v1 = g1 * acc[ai][bj][m][1];
                if (ADD) { f32x4 p0, p1; unpack8(mg[g & 1][i], p0, p1); v0 += p0; v1 += p1; }
                *(u32x4*)(MG + off) = pack8(v0, v1); }
            PG8_MEMFENCE();
        }
#undef PG8_ISSUE
#undef PG8_OFF
    }
};
template <bool RMW> struct EpiResid {
    static constexpr int NSTORE = 32;
    const float* Xin; float* Xout; const float* GT;
    __device__ __forceinline__ void operator()(AccRef acc, const Unit& u, int wr, int wc, int fr, int fq) const {
        const int row0 = u.pm * BM + wr * 64 + fr, col0 = u.pn * BM + wc * 32 + 8 * fq; const float* gt = GT + (size_t)(u.pm >> 3) * 6144;
        f32x4 t[2][2];
#pragma unroll
        for (int bj = 0; bj < 2; ++bj) { t[bj][0] = *(const f32x4*)(gt + col0 + bj * HALF); t[bj][1] = *(const f32x4*)(gt + col0 + bj * HALF + 4); }
        f32x4 xb[2][4][2];
#define PG8_OFF(idx) ({ PG8_ITEM(idx, ai_, m_, bj_); (size_t)(row0 + ai_ * HALF + m_ * 16) * 1024 + col0 + bj_ * HALF; })
#define PG8_ISSUE(g) do { _Pragma("unroll") for (int i_ = 0; i_ < 4; ++i_) { const size_t off_ = PG8_OFF(4 * (g) + i_); xb[(g) & 1][i_][0] = *(const f32x4*)(Xin + off_); xb[(g) & 1][i_][1] = *(const f32x4*)(Xin + off_ + 4); } } while (0)
        PG8_ISSUE(0); PG8_MEMFENCE();
#pragma unroll
        for (int g = 0; g < 4; ++g) {
            if (g < 3) PG8_ISSUE(g + 1);
            PG8_MEMFENCE();
#pragma unroll
            for (int i = 0; i < 4; ++i) { PG8_ITEM(4 * g + i, ai, m, bj); const size_t off = PG8_OFF(4 * g + i);
                *(f32x4*)(Xout + off) = xb[g & 1][i][0] + t[bj][0] * acc[ai][bj][m][0]; *(f32x4*)(Xout + off + 4) = xb[g & 1][i][1] + t[bj][1] * acc[ai][bj][m][1]; }
            PG8_MEMFENCE();
        }
#undef PG8_ISSUE
#undef PG8_OFF
    }
};
__device__ __forceinline__ void swiglu_store(AccRef acc, bf16_t* H, int row0, int hc0) {
#pragma unroll
    for (int ai = 0; ai < 2; ++ai)
#pragma unroll
        for (int m = 0; m < 4; ++m) { f32x4 v[2];
#pragma unroll
            for (int n = 0; n < 2; ++n) { const f32x4 gg = acc[ai][0][m][n], uu = acc[ai][1][m][n]; v[n] = gg * sig4(gg) * uu; }
            *(u32x4*)(H + (size_t)(row0 + ai * HALF + m * 16) * 256 + hc0) = pack8(v[0], v[1]); }
}
struct EpiRouterShared {
    static constexpr int NSTORE = 32;
    float* SC; bf16_t* HS;
    __device__ __forceinline__ void operator()(AccRef acc, const Unit& u, int wr, int wc, int fr, int fq) const {
        const int row0 = u.pm * BM + wr * 64 + fr;
        if (u.pn == 0) {
#pragma unroll
            for (int ai = 0; ai < 2; ++ai)
#pragma unroll
                for (int m = 0; m < 4; ++m)
#pragma unroll
                    for (int bj = 0; bj < 2; ++bj) { float* p = SC + (size_t)(row0 + ai * HALF + m * 16) * 256 + bj * HALF + wc * 32 + 8 * fq;
                        *(f32x4*)p = sig4(acc[ai][bj][m][0]); *(f32x4*)(p + 4) = sig4(acc[ai][bj][m][1]); }
        } else swiglu_store(acc, HS, row0, (u.pn - 1) * HALF + wc * 32 + 8 * fq);
    }
};
struct EpiExpert1 {
    static constexpr int NSTORE = 8;
    bf16_t* HID;
    __device__ __forceinline__ void operator()(AccRef acc, const Unit& u, int wr, int wc, int fr, int fq) const { swiglu_store(acc, HID, u.pm * BM + wr * 64 + fr, u.pn * HALF + wc * 32 + 8 * fq); }
};
struct EpiExpert2 {
    static constexpr int NSTORE = 16;
    bf16_t* Y;
    __device__ __forceinline__ void operator()(AccRef acc, const Unit& u, int wr, int wc, int fr, int fq) const {
        const int row0 = u.pm * BM + wr * 64 + fr, col0 = u.pn * BM + wc * 32 + 8 * fq;
#pragma unroll
        for (int ai = 0; ai < 2; ++ai)
#pragma unroll
            for (int m = 0; m < 4; ++m)
#pragma unroll
                for (int bj = 0; bj < 2; ++bj) *(u32x4*)(Y + (size_t)(row0 + ai * HALF + m * 16) * 1024 + col0 + bj * HALF) = pack8(acc[ai][bj][m][0], acc[ai][bj][m][1]);
    }
};
}
#include <hip/hip_bf16.h>
#include <cmath>
namespace attn_body {
using bf16=__hip_bfloat16;
using bf16x8=__attribute__((ext_vector_type(8)))short;
using s16x4=__attribute__((ext_vector_type(4)))short;
using f32x16=__attribute__((ext_vector_type(16)))float;
using u32x4=__attribute__((ext_vector_type(4)))unsigned;
constexpr int BATCH=16,NHEAD=8,SEQ=2048,D=64,QP=512,KP=128,OP=512,GQA=4;
constexpr int NW=8,QBLK=32,QB=QBLK*NW,KVBLK=64,NQB=SEQ/QB;
constexpr int ATTN_UNIT_ROWS=QB;
__device__ __forceinline__ int crow(int r,int hi){return (r&3)+8*(r>>2)+4*hi;}
#define SBAR() __builtin_amdgcn_sched_barrier(0)
constexpr int NSLOT=3, SLOTB=8192;
constexpr int LDS_K=0, LDS_V=NSLOT*SLOTB, LDS_WS=2*NSLOT*SLOTB, LDS_OST=LDS_WS+NW*64*4, LDS_BYTES=LDS_OST+NW*4096;
constexpr float C2=0.125f*1.4426950408889634f;
__device__ __forceinline__ void glds16(const void*gsrc,unsigned lds_dst){unsigned keep;
  asm volatile("s_mov_b32 %0, m0\n\ts_mov_b32 m0, %2\n\ts_nop 0\n\tglobal_load_lds_dwordx4 %1, off\n\ts_mov_b32 m0, %0":"=&s"(keep):"v"(gsrc),"s"(lds_dst):"memory");}
__device__ __forceinline__ float max3f(float a,float b,float c){float r;asm("v_max3_f32 %0, %1, %2, %3":"=v"(r):"v"(a),"v"(b),"v"(c));return r;}
__device__ __forceinline__ float max2f(float a,float b){float r;asm("v_max_f32_e32 %0, %1, %2":"=v"(r):"v"(a),"v"(b));return r;}
__device__ __forceinline__ float fadd_s(float a,float b){float r;asm("v_add_f32_e32 %0, %1, %2":"=v"(r):"v"(a),"v"(b));return r;}
__device__ __forceinline__ float fsub_s(float a,float b){float r;asm("v_sub_f32_e32 %0, %1, %2":"=v"(r):"v"(a),"v"(b));return r;}
typedef float f32x2_t __attribute__((ext_vector_type(2))); typedef __bf16 bf16x2_t __attribute__((ext_vector_type(2)));
__device__ __forceinline__ unsigned cvtpk_s(float lo,float hi){f32x2_t v={lo,hi};bf16x2_t b=__builtin_convertvector(v,bf16x2_t);return __builtin_bit_cast(unsigned,b);}
#define WAIT_BAR(N) asm volatile("s_waitcnt vmcnt(" #N ") lgkmcnt(0)\n\ts_barrier":::"memory")

__device__ __forceinline__ void qkt(f32x16&p0,f32x16&p1,const char*Kslot,const bf16x8*qr,const f32x16&negm,int r32,int hi){
  const char*kb=Kslot+hi*1024+r32*16;
  #pragma unroll
  for(int d0=0;d0<4;++d0){
    const bf16x8 b0=*reinterpret_cast<const bf16x8*>(kb+d0*2048);
    const bf16x8 b1=*reinterpret_cast<const bf16x8*>(kb+d0*2048+512);
    if(d0==0){p0=__builtin_amdgcn_mfma_f32_32x32x16_bf16(b0,qr[0],negm,0,0,0);p1=__builtin_amdgcn_mfma_f32_32x32x16_bf16(b1,qr[0],negm,0,0,0);}
    else{p0=__builtin_amdgcn_mfma_f32_32x32x16_bf16(b0,qr[d0],p0,0,0,0);p1=__builtin_amdgcn_mfma_f32_32x32x16_bf16(b1,qr[d0],p1,0,0,0);}}
}
typedef __attribute__((address_space(3))) const char* lds_cptr;
typedef short v4i16_t __attribute__((ext_vector_type(4)));
__device__ __forceinline__ void kload8(bf16x8*kf,lds_cptr kp){
  kf[0]=*(const __attribute__((address_space(3))) bf16x8*)(kp);      kf[1]=*(const __attribute__((address_space(3))) bf16x8*)(kp+512);
  kf[2]=*(const __attribute__((address_space(3))) bf16x8*)(kp+2048); kf[3]=*(const __attribute__((address_space(3))) bf16x8*)(kp+2560);
  kf[4]=*(const __attribute__((address_space(3))) bf16x8*)(kp+4096); kf[5]=*(const __attribute__((address_space(3))) bf16x8*)(kp+4608);
  kf[6]=*(const __attribute__((address_space(3))) bf16x8*)(kp+6144); kf[7]=*(const __attribute__((address_space(3))) bf16x8*)(kp+6656);
}
__device__ __forceinline__ void kload2(bf16x8*kf,lds_cptr kp,int j){ kf[2*j]=*(const __attribute__((address_space(3))) bf16x8*)(kp+j*2048); kf[2*j+1]=*(const __attribute__((address_space(3))) bf16x8*)(kp+j*2048+512); }
__device__ __forceinline__ s16x4 vtr(lds_cptr p){ return __builtin_bit_cast(s16x4,__builtin_amdgcn_ds_read_tr16_b64_v4i16((__attribute__((address_space(3))) v4i16_t*)p)); }
__device__ __forceinline__ float rowmax(const f32x16&p0,const f32x16&p1){
  float a=max3f(p0[0],p0[1],p1[0]),b=max3f(p0[2],p0[3],p1[1]);a=max3f(a,p1[2],p1[3]);
  #pragma unroll
  for(int r=4;r<16;r+=4){a=max3f(a,p0[r],p0[r+1]);b=max3f(b,p0[r+2],p0[r+3]);a=max3f(a,p1[r],p1[r+1]);b=max3f(b,p1[r+2],p1[r+3]);}
  const float m=max2f(a,b);
  auto rr=__builtin_amdgcn_permlane32_swap(__float_as_uint(m),__float_as_uint(m),false,false);
  return max2f(__uint_as_float(rr[0]),__uint_as_float(rr[1]));
}
__device__ __forceinline__ void pv(f32x16*o,int vb,bf16x8 pa0,bf16x8 pa1,bf16x8 pa2,bf16x8 pa3){
  #pragma unroll
  for(int d0=0;d0<2;++d0){s16x4 lo[4],hi[4];
    #pragma unroll
    for(int ks=0;ks<4;++ks){
      asm volatile("ds_read_b64_tr_b16 %0,%1 offset:%c2":"=&v"(lo[ks]):"v"(vb),"i"(d0*4096+ks*1024):"memory");
      asm volatile("ds_read_b64_tr_b16 %0,%1 offset:%c2":"=&v"(hi[ks]):"v"(vb),"i"(d0*4096+ks*1024+512):"memory");}
    asm volatile("s_waitcnt lgkmcnt(0)":::"memory");SBAR();
    #define PK(k) (bf16x8){lo[k][0],lo[k][1],lo[k][2],lo[k][3],hi[k][0],hi[k][1],hi[k][2],hi[k][3]}
    o[d0]=__builtin_amdgcn_mfma_f32_32x32x16_bf16(pa0,PK(0),o[d0],0,0,0);
    o[d0]=__builtin_amdgcn_mfma_f32_32x32x16_bf16(pa1,PK(1),o[d0],0,0,0);
    o[d0]=__builtin_amdgcn_mfma_f32_32x32x16_bf16(pa2,PK(2),o[d0],0,0,0);
    o[d0]=__builtin_amdgcn_mfma_f32_32x32x16_bf16(pa3,PK(3),o[d0],0,0,0);
    #undef PK
  }
}

#ifndef ATTN_STORE16
#define ATTN_STORE16(p,v) (*(u32x4*)(p)=(v))
#endif
template<int THRL> __device__ __forceinline__ void attn_unit(int b,int h,int qb,const bf16*Q,const bf16*__restrict__ K,const bf16*__restrict__ V,bf16*O,char*shm,const int tid){
  const int lane=tid&63,r32=lane&31,hi=lane>>5; const int wid=__builtin_amdgcn_readfirstlane(tid>>6);
  const long rowbase=(long)b*SEQ; const int q0=qb*QB;
  const bf16*Qw=Q+(rowbase+q0+wid*QBLK)*QP+h*D;
  const bf16*Kh=K+rowbase*KP+(h/GQA)*D,*Vh=V+rowbase*KP+(h/GQA)*D;
  const unsigned lds0=(unsigned)(uintptr_t)shm;
  float*wsf=(float*)(shm+LDS_WS)+wid*64;
  const bf16*ksrc=Kh+(long)lane*KP+wid*8;
  const bf16*vsrc=Vh+(long)(16*(wid&3)+(lane>>2))*KP+(wid>>2)*32+(lane&3)*8;
  const unsigned kdst=lds0+LDS_K+wid*1024, vdst=lds0+LDS_V+wid*1024;
  #define DMA_K(t,slot) glds16(ksrc+(long)(t)*KVBLK*KP,(unsigned)__builtin_amdgcn_readfirstlane(kdst+(slot)))
  #define DMA_V(t,slot) glds16(vsrc+(long)(t)*KVBLK*KP,(unsigned)__builtin_amdgcn_readfirstlane(vdst+(slot)))
  const int vb0=(int)(lds0+LDS_V)+((lane>>4)&1)*32+(lane&3)*8+(4*hi+((lane&15)>>2))*64;
  const char*Kbase=shm+LDS_K; bf16x8 kf[8];
  const lds_cptr shm3=(lds_cptr)shm; const lds_cptr kp0=shm3+LDS_K+hi*1024+r32*16; const lds_cptr vp0=shm3+LDS_V+((lane>>4)&1)*32+(lane&3)*8+(4*hi+((lane&15)>>2))*64;
  const int NT=SEQ/KVBLK;
  DMA_K(0,0);DMA_V(0,0);DMA_K(1,SLOTB);
  bf16x8 qr[4];
  #pragma unroll
  for(int d0=0;d0<4;++d0)qr[d0]=*reinterpret_cast<const bf16x8*>(&Qw[(long)r32*QP+d0*16+hi*8]);
  float mhat=0.f,l_reg=0.f;f32x16 o[2];o[0]=f32x16{};o[1]=f32x16{};f32x16 negm=f32x16{};asm volatile("":"+v"(negm));
    #define CMASK(P0,P1,t) do{}while(0)
  bool resc=false;
  #define START(P0,P1) do{ const float rm=rowmax(P0,P1); resc=false; \
    { const float dl=rm; mhat=fadd_s(mhat,dl); \
      _Pragma("unroll") for(int r=0;r<16;++r){P0[r]=fsub_s(P0[r],dl);P1[r]=fsub_s(P1[r],dl);} \
      _Pragma("unroll") for(int r=0;r<16;++r)negm[r]=-mhat; asm volatile("":"+v"(negm)); } \
    _Pragma("unroll") for(int r=0;r<16;++r)P0[r]=__builtin_amdgcn_exp2f(P0[r]); }while(0)
  #define RESC() do{ if(resc){ asm volatile("s_waitcnt lgkmcnt(0)":::"memory"); \
      _Pragma("unroll") for(int d_=0;d_<2;++d_) _Pragma("unroll") for(int r=0;r<16;++r)o[d_][r]*=wsf[crow(r,hi)]; } }while(0)
  f32x16 pA0,pA1,pB0,pB1;
  int sl_prev=0,sl_cur=0,sl_next=SLOTB;
  #define ROT() do{sl_prev=sl_cur;sl_cur=sl_next;sl_next=(sl_next==(NSLOT-1)*SLOTB)?0:sl_next+SLOTB;}while(0)
  DMA_K(2,2*SLOTB);
  WAIT_BAR(3);
  qkt(pA0,pA1,Kbase,qr,negm,r32,hi);asm volatile("s_nop 15\n\ts_nop 7":"+v"(pA0),"+v"(pA1));CMASK(pA0,pA1,0);
  START(pA0,pA1);
  _Pragma("unroll") for(int r=0;r<16;++r)pA1[r]=__builtin_amdgcn_exp2f(pA1[r]);
  WAIT_BAR(0);
  DMA_K(3,0);DMA_V(1,SLOTB);
  ROT();
  kload8(kf,kp0+sl_cur);
  WAIT_BAR(2);
  s16x4 vlo[8],vhi[8]; u32x4 pw0,pw1,pw2,pw3;
  #define PKW(P,B) cvtpk_s(P[B],P[B+1])
  #define PAF(k) __builtin_bit_cast(bf16x8,pw##k)
  #define VFR(i) (bf16x8){vlo[i][0],vlo[i][1],vlo[i][2],vlo[i][3],vhi[i][0],vhi[i][1],vhi[i][2],vhi[i][3]}
  #define PIN(x) asm volatile("":"+v"(x))
  #define MX3(a,b,c) __builtin_fmaxf(__builtin_fmaxf((a),(b)),(c))
  #define GAPA(MF,A0,A1,A2,A3,W0,W1,PW) do{ MF; sacc+=A0; sacc+=A1; sacc+=A2; sacc+=A3; PIN(sacc); W0; W1; PIN(PW); SBAR(); }while(0)
  #define EX(v) __builtin_amdgcn_exp2f(v)
  #define GAPB(MF,X,B) do{ MF; X[B]=EX(X[B]); X[B+1]=EX(X[B+1]); X[B+2]=EX(X[B+2]); X[B+3]=EX(X[B+3]); PIN(X); SBAR(); }while(0)
  #define VRD(i) do{ vlo[i]=vtr(vp_+(((i)>>2)*4096+((i)&3)*1024)); vhi[i]=vtr(vp_+(((i)>>2)*4096+((i)&3)*1024+512)); }while(0)
  #define KRD(G,j) do{ if(G){ kload2(kf,kp0+sl_next,j); SBAR(); } }while(0)
  #define STEP(C0,C1,P0,P1,t,GK,GV,GL) do{ SBAR(); \
    const lds_cptr vp_=vp0+sl_prev; \
    VRD(0); SBAR(); float sacc=(P0[0]+P0[1]); \
    GAPA(C0=__builtin_amdgcn_mfma_f32_32x32x16_bf16(kf[0],qr[0],negm,0,0,0), P0[2],P0[3],P0[4],P0[5],     pw0[0]=PKW(P0,0), pw0[1]=PKW(P0,2), pw0); \
    VRD(4); SBAR(); GAPA(C1=__builtin_amdgcn_mfma_f32_32x32x16_bf16(kf[1],qr[0],negm,0,0,0), P0[6],P0[7],P0[8],P0[9],     pw0[2]=PKW(P0,4), pw0[3]=PKW(P0,6), pw0); \
    VRD(1); SBAR(); GAPA(C0=__builtin_amdgcn_mfma_f32_32x32x16_bf16(kf[2],qr[1],C0,0,0,0),   P0[10],P0[11],P0[12],P0[13], pw1[0]=PKW(P0,8), pw1[1]=PKW(P0,10), pw1); \
    VRD(5); SBAR(); GAPA(C1=__builtin_amdgcn_mfma_f32_32x32x16_bf16(kf[3],qr[1],C1,0,0,0),   P0[14],P0[15],P1[0],P1[1],   pw1[2]=PKW(P0,12),pw1[3]=PKW(P0,14), pw1); \
    VRD(2); SBAR(); GAPA(C0=__builtin_amdgcn_mfma_f32_32x32x16_bf16(kf[4],qr[2],C0,0,0,0),   P1[2],P1[3],P1[4],P1[5],     pw2[0]=PKW(P1,0), pw2[1]=PKW(P1,2), pw2); \
    VRD(6); SBAR(); GAPA(C1=__builtin_amdgcn_mfma_f32_32x32x16_bf16(kf[5],qr[2],C1,0,0,0),   P1[6],P1[7],P1[8],P1[9],     pw2[2]=PKW(P1,4), pw2[3]=PKW(P1,6), pw2); \
    VRD(3); SBAR(); GAPA(C0=__builtin_amdgcn_mfma_f32_32x32x16_bf16(kf[6],qr[3],C0,0,0,0),   P1[10],P1[11],P1[12],P1[13], pw3[0]=PKW(P1,8), pw3[1]=PKW(P1,10), pw3); \
    VRD(7); SBAR(); GAPA(C1=__builtin_amdgcn_mfma_f32_32x32x16_bf16(kf[7],qr[3],C1,0,0,0),   P1[14],P1[15],0.f,0.f,       pw3[2]=PKW(P1,12),pw3[3]=PKW(P1,14), pw3); \
    l_reg+=sacc; \
    if(GK){DMA_K((t)+3,sl_cur);} if(GV){DMA_V((t)+1,sl_next);} \
    CMASK(C0,C1,t); \
    { float a=MX3(C0[0],C0[1],C1[0]),b=MX3(C0[2],C0[3],C1[1]); a=MX3(a,C1[2],C1[3]); \
      _Pragma("unroll") for(int r=4;r<16;r+=4){a=MX3(a,C0[r],C0[r+1]);b=MX3(b,C0[r+2],C0[r+3]);a=MX3(a,C1[r],C1[r+1]);b=MX3(b,C1[r+2],C1[r+3]);} \
      float rm=__builtin_fmaxf(a,b); { auto rr=__builtin_amdgcn_permlane32_swap(__float_as_uint(rm),__float_as_uint(rm),false,false); rm=__builtin_fmaxf(__uint_as_float(rr[0]),__uint_as_float(rr[1])); } \
      resc=false; \
      if(__builtin_expect(__any(rm>(float)THRL),0)){ const float dl=__builtin_fmaxf(rm,0.f); mhat+=dl; \
        _Pragma("unroll") for(int r=0;r<16;++r){C0[r]-=dl;C1[r]-=dl;} \
        _Pragma("unroll") for(int r=0;r<16;++r)negm[r]=-mhat; asm volatile("":"+v"(negm)); \
        const float f=__builtin_amdgcn_exp2f(-dl); l_reg*=f; if(hi==0)wsf[r32]=f; resc=true; } } \
    SBAR(); \
    GAPB(o[0]=__builtin_amdgcn_mfma_f32_32x32x16_bf16(PAF(0),VFR(0),o[0],0,0,0), C0,0); \
    GAPB(o[1]=__builtin_amdgcn_mfma_f32_32x32x16_bf16(PAF(0),VFR(4),o[1],0,0,0), C0,4); \
    KRD(GL,0); GAPB(o[0]=__builtin_amdgcn_mfma_f32_32x32x16_bf16(PAF(1),VFR(1),o[0],0,0,0), C0,8); \
    KRD(GL,1); GAPB(o[1]=__builtin_amdgcn_mfma_f32_32x32x16_bf16(PAF(1),VFR(5),o[1],0,0,0), C0,12); \
    KRD(GL,2); GAPB(o[0]=__builtin_amdgcn_mfma_f32_32x32x16_bf16(PAF(2),VFR(2),o[0],0,0,0), C1,0); \
    KRD(GL,3); GAPB(o[1]=__builtin_amdgcn_mfma_f32_32x32x16_bf16(PAF(2),VFR(6),o[1],0,0,0), C1,4); \
    GAPB(o[0]=__builtin_amdgcn_mfma_f32_32x32x16_bf16(PAF(3),VFR(3),o[0],0,0,0), C1,8); \
    GAPB(o[1]=__builtin_amdgcn_mfma_f32_32x32x16_bf16(PAF(3),VFR(7),o[1],0,0,0), C1,12); \
    }while(0)
  int t=1;
  #undef CMASK
  #define CMASK(P0,P1,t) do{}while(0)
  for(;t+5<NT;t+=2){
    STEP(pB0,pB1,pA0,pA1,t,true,true,true);     WAIT_BAR(2); RESC(); ROT();
    STEP(pA0,pA1,pB0,pB1,t+1,true,true,true);   WAIT_BAR(2); RESC(); ROT();
  }
  #undef CMASK
  #define CMASK(P0,P1,t) do{}while(0)
  #define ENDW(tt) do{ if((tt)+3<NT){WAIT_BAR(2);} else if((tt)+2<NT){WAIT_BAR(1);} else {WAIT_BAR(0);} }while(0)
  for(;t+1<NT;t+=2){
    STEP(pB0,pB1,pA0,pA1,t,(t+3<NT),(t+1<NT),(t+1<NT));       ENDW(t);   RESC(); ROT();
    STEP(pA0,pA1,pB0,pB1,t+1,(t+4<NT),(t+2<NT),(t+2<NT));     ENDW(t+1); RESC(); ROT();
  }
  STEP(pB0,pB1,pA0,pA1,NT-1,false,false,false); RESC();
  { float sacc=pB0[0]+pB0[1]; _Pragma("unroll") for(int r=2;r<16;++r)sacc+=pB0[r]; _Pragma("unroll") for(int r=0;r<16;++r)sacc+=pB1[r]; l_reg+=sacc;
    pw0=(u32x4){PKW(pB0,0),PKW(pB0,2),PKW(pB0,4),PKW(pB0,6)};pw1=(u32x4){PKW(pB0,8),PKW(pB0,10),PKW(pB0,12),PKW(pB0,14)};pw2=(u32x4){PKW(pB1,0),PKW(pB1,2),PKW(pB1,4),PKW(pB1,6)};pw3=(u32x4){PKW(pB1,8),PKW(pB1,10),PKW(pB1,12),PKW(pB1,14)};
    SBAR(); pv(o,vb0+sl_cur,PAF(0),PAF(1),PAF(2),PAF(3)); }
  #undef PKW
  #undef PAF
  #undef VFR
  #undef PIN
  #undef MX3
  #undef GAPA
  #undef GAPB
  #undef EX
  #undef VRD
  #undef KRD
  #undef STEP
  #undef ENDW
  {auto rr=__builtin_amdgcn_permlane32_swap(__float_as_uint(l_reg),__float_as_uint(l_reg),false,false);l_reg=__uint_as_float(rr[0])+__uint_as_float(rr[1]);}
  if(hi==0)wsf[32+r32]=l_reg;asm volatile("s_waitcnt lgkmcnt(0)":::"memory");
  float rli[16];
  #pragma unroll
  for(int r=0;r<16;++r)rli[r]=__builtin_amdgcn_rcpf(wsf[32+crow(r,hi)]);
  bf16*Ow=O+(rowbase+q0+wid*QBLK)*OP+h*D;
  { bf16*stg=(bf16*)(shm+LDS_OST)+wid*2048;
    #pragma unroll
    for(int r=0;r<16;++r){const int orow=crow(r,hi);
      #pragma unroll
      for(int d0=0;d0<2;++d0)stg[orow*64+d0*32+r32]=__float2bfloat16(o[d0][r]*rli[r]);}
    asm volatile("s_waitcnt lgkmcnt(0)":::"memory");
    #pragma unroll
    for(int i=0;i<4;++i){const int row=i*8+(lane>>3),ch=lane&7; const u32x4 v=*(const u32x4*)(stg+row*64+ch*8); ATTN_STORE16(Ow+(long)row*OP+ch*8,v);} }
  asm volatile("s_waitcnt lgkmcnt(0)\n\ts_barrier":::"memory");
  #undef DMA_K
  #undef DMA_V
  #undef CMASK
  #undef START
  #undef RESC
  #undef ROT
}
constexpr int ATTN_LDS_BYTES=LDS_BYTES;
struct AttnTensors { const bf16* Q; const bf16* K; const bf16* V; bf16* O; };
struct AttnUnit { int bh; int qb; };
struct StaticOrder {
  int vcu;
  __device__ __forceinline__ explicit StaticOrder(int grid,int block):vcu((block%8)*(grid/8)+block/8){}
  __device__ __forceinline__ bool next(int i,AttnUnit&u)const{ if(i>=4)return false; const int pair=vcu>>3; u.bh=(pair>>1)*NHEAD+(pair&1)*GQA+i; u.qb=vcu&7; return true; }
  __device__ __forceinline__ void a_ready(const AttnUnit&)const{}
  __device__ __forceinline__ void done(const AttnUnit&)const{}
};
template<class Sched,int THRL=8> __device__ __forceinline__ void attn_phase(char*lds,const AttnTensors&T,const Sched&S,const int tid){
  AttnUnit u;
  for(int i=0;S.next(i,u);++i){ S.a_ready(u); attn_unit<THRL>(u.bh/NHEAD,u.bh%NHEAD,u.qb,T.Q,T.K,T.V,T.O,lds,tid); S.done(u); }
}
#undef SBAR
#undef WAIT_BAR
}
#define GAS __attribute__((address_space(1)))
#define LAS __attribute__((address_space(3)))
typedef unsigned short bf16;
typedef unsigned v4u __attribute__((ext_vector_type(4)));
typedef float f32x4 __attribute__((ext_vector_type(4)));
typedef GAS unsigned gu32;
#define RLX_AGENT __ATOMIC_RELAXED, __HIP_MEMORY_SCOPE_AGENT
#define LDS_WAIT() asm volatile("s_waitcnt lgkmcnt(0)" ::: "memory")

constexpr int NWAVES = 8;
constexpr int DM = 1024, NB = 16, SEQ = 2048, T = NB * SEQ;
constexpr int IN_COLS = 4352, NMOD = 6 * DM;
constexpr int NEXP = 256, TOPK = 8, EFF = 256;
constexpr int NSLOT_MAX = T * TOPK + NEXP * 255;
constexpr int NTILE_MAX = NSLOT_MAX / 256;
constexpr float EPS = 1e-6f, ROUTED_SCALE = 2.5f;
static_assert(NSLOT_MAX % 256 == 0, "slot space");

constexpr size_t MiB = 1u << 20;
constexpr size_t WS_CTL = 0, CTL_ZERO_BYTES = 64 * 1024;
constexpr size_t WS_MOD = 1 * MiB;
constexpr size_t WS_TBL = 1 * MiB + 512 * 1024;
constexpr size_t WS_TILE_E = WS_TBL + 16 * 1024;
constexpr size_t WS_IDX = 2 * MiB, WS_WTS = 3 * MiB, WS_SLOT = 4 * MiB;
constexpr size_t WS_SLOT_TOK = 5 * MiB;
constexpr size_t WS_HIST = 7 * MiB;
constexpr size_t WS_WIN = 16 * MiB;
constexpr size_t WS_WAO = 25 * MiB, WS_WCO = 26 * MiB;
constexpr size_t WS_WOUT = 27 * MiB;
constexpr size_t WS_WRS = 29 * MiB;
constexpr size_t WS_WSD = 31 * MiB;
constexpr size_t WS_WED = 32 * MiB;
constexpr size_t WS_HID = 160 * MiB;
constexpr size_t WS_H = 320 * MiB;
constexpr size_t WS_WE1 = 384 * MiB;
constexpr size_t WS_Q = 640 * MiB, WS_K = 672 * MiB, WS_V = 680 * MiB;
constexpr size_t WS_CB = 688 * MiB, WS_CC = 720 * MiB, WS_CX = 752 * MiB;
constexpr size_t WS_SGA = 784 * MiB, WS_SGC = 848 * MiB;
constexpr size_t WS_MG = 912 * MiB;
constexpr size_t WS_SC = 976 * MiB;
constexpr size_t WS_HS = 1008 * MiB;
constexpr size_t WS_Y = 384 * MiB;
constexpr size_t WS_O = WS_Q;
constexpr size_t WS_END = 1024 * MiB;
static_assert(WS_HID + (size_t)NSLOT_MAX * 512 <= WS_H && WS_Y + (size_t)NSLOT_MAX * 2048 <= WS_END && WS_SLOT_TOK + (size_t)NSLOT_MAX * 4 <= WS_HIST, "d_ws map");
constexpr int CW_NTILES = 16, CW_BAR = 4096;

constexpr int RING_BYTES = 131072, MISC_OFF = RING_BYTES, LDS_BYTES = 147456;
constexpr int L_HIST = 0, L_PAD = 1024, L_BASE = 2048, L_PS = 3072, L_BARST = 4112, L_TILEE = 4352;
static_assert(MISC_OFF + L_TILEE + (NTILE_MAX + 1) * 4 <= LDS_BYTES, "LDS map");

struct Args {
    const float *x, *c, *w_ada, *b_ada, *g_mix, *w_in, *qg, *kg, *conv_w, *w_attn_o, *w_conv_o, *w_out, *g_ffn, *w_router, *r_bias, *w_gate_e, *w_up_e, *w_down_e, *w_gate_s, *w_up_s, *w_down_s;
    float* out; unsigned char* ws;
};

template <int MASK> __device__ __forceinline__ unsigned swz_xor_u(unsigned v) { return (unsigned)__builtin_amdgcn_ds_swizzle((int)v, (MASK << 10) | 0x1f); }
template <int MASK> __device__ __forceinline__ float swz_xor_f(float v) { return __uint_as_float(swz_xor_u<MASK>(__float_as_uint(v))); }
__device__ __forceinline__ float wave_sum(float v) {
    v += swz_xor_f<1>(v); v += swz_xor_f<2>(v); v += swz_xor_f<4>(v); v += swz_xor_f<8>(v); v += swz_xor_f<16>(v);
    auto rr = __builtin_amdgcn_permlane32_swap(__float_as_uint(v), __float_as_uint(v), false, false);
    return __uint_as_float(rr[0]) + __uint_as_float(rr[1]);
}
__device__ __forceinline__ float bcast_f(float v, int srclane) { return __int_as_float(__builtin_amdgcn_readlane(__float_as_int(v), srclane)); }
__device__ __forceinline__ unsigned pk2(float lo, float hi) { return pg8::cvt_pk_bf16(lo, hi); }

#define XB_TMO      128
#define XB_XCNT(j)  (256  + 64 * (j))
#define XB_XSUB(j)  (1280 + 64 * (j))
#define XB_XGEN(j)  (2304 + 64 * (j))
#define XB_TOP      3328
#define XB_TOPGEN   3392
#define XCD_BAR_WORDS 3456
#define XB_SPIN_CAP (1u << 18)

__device__ __forceinline__ unsigned xb_ld(unsigned* p)              { return __hip_atomic_load(p, __ATOMIC_RELAXED, __HIP_MEMORY_SCOPE_AGENT); }
__device__ __forceinline__ unsigned xb_add(unsigned* p, unsigned v) { return __hip_atomic_fetch_add(p, v, __ATOMIC_RELAXED, __HIP_MEMORY_SCOPE_AGENT); }
__device__ __forceinline__ unsigned xb_xcc_id() { return (unsigned)__builtin_amdgcn_s_getreg((3 << 11) | 20) & 0xFu; }
#define XB_SPIN(cond, bar) do { unsigned _sp = 0; while (cond) { __builtin_amdgcn_s_sleep(1); \
    if ((++_sp & 255u) == 0u) { if (xb_ld(&(bar)[XB_TMO])) break; if (_sp > XB_SPIN_CAP) { atomicAdd(&(bar)[XB_TMO], 1u); break; } } } } while (0)

struct XcdBarrier {
    unsigned* bar; unsigned x;
    volatile LAS unsigned* st;
};

__device__ __forceinline__ XcdBarrier xcd_barrier_post(unsigned* bar, volatile LAS unsigned* st, int tid) {
    XcdBarrier b; b.bar = bar; b.x = xb_xcc_id(); b.st = st;
    if (tid == 0) (void)xb_add(&bar[XB_XCNT(b.x)], 1u);
    return b;
}
__device__ __forceinline__ void xcd_barrier_complete(unsigned* bar, unsigned x, unsigned& nloc, unsigned& nx) {
    const unsigned G = gridDim.x * gridDim.y * gridDim.z;
    unsigned sum, cnt, mine, sp = 0u;
    for (;;) {
        sum = 0u; cnt = 0u; mine = 0u;
#pragma unroll
        for (unsigned j = 0; j < 16; ++j) { const unsigned c = xb_ld(&bar[XB_XCNT(j)]); sum += c; cnt += (c > 0u) ? 1u : 0u; mine = (j == x) ? c : mine; }
        if (sum == G) break;
        __builtin_amdgcn_s_sleep(1);
        if ((++sp & 255u) == 0u) { if (xb_ld(&bar[XB_TMO])) break; if (sp > XB_SPIN_CAP) { atomicAdd(&bar[XB_TMO], 1u); break; } }
    }
    nloc = mine > 0u ? mine : 1u; nx = cnt > 0u ? cnt : 1u;
}

__device__ __forceinline__ void xcd_barrier(const XcdBarrier& b, int tid) {
    asm volatile("s_waitcnt vmcnt(0)" ::: "memory");
    __syncthreads();
    if (tid == 0) {
        unsigned* bar = b.bar;
        __builtin_amdgcn_s_waitcnt(0);
        unsigned nloc = b.st[0], nx = b.st[1];
        if (nloc == 0u) { xcd_barrier_complete(bar, b.x, nloc, nx); b.st[0] = nloc; b.st[1] = nx; }
        const unsigned old = xb_add(&bar[XB_XSUB(b.x)], 1u);
        const unsigned gen = old / nloc;
        if (old + 1u == (gen + 1u) * nloc) {
            __builtin_amdgcn_fence(__ATOMIC_RELEASE, "agent");
            asm volatile("s_waitcnt vmcnt(0)" ::: "memory");
            const unsigned og = xb_add(&bar[XB_TOP], 1u);
            const unsigned tg = og / nx;
            if (og + 1u == (tg + 1u) * nx) xb_add(&bar[XB_TOPGEN], 1u);
            else XB_SPIN(xb_ld(&bar[XB_TOPGEN]) == tg, bar);
            __builtin_amdgcn_fence(__ATOMIC_ACQUIRE, "agent");
            xb_add(&bar[XB_XGEN(b.x)], 1u);
            asm volatile("s_waitcnt vmcnt(0)" ::: "memory");
        } else {
            XB_SPIN(xb_ld(&bar[XB_XGEN(b.x)]) == gen, bar);
            __builtin_amdgcn_fence(__ATOMIC_ACQUIRE, "agent");
            asm volatile("s_waitcnt vmcnt(0)" ::: "memory");
        }
    }
    __syncthreads();
}

struct TDesc { const float* src; bf16* dst; int N, ldt; };
__device__ __forceinline__ void tt_load(const TDesc& d, int lane, f32x4 (&a)[8], f32x4 (&b)[8]) {
    const int q = lane & 15, kq = lane >> 4;
#pragma unroll
    for (int r = 0; r < 8; ++r) { const int kp = kq + 4 * r; a[r] = *(const f32x4*)(d.src + (size_t)(2 * kp) * d.N + 4 * q); b[r] = *(const f32x4*)(d.src + (size_t)(2 * kp + 1) * d.N + 4 * q); }
}
__device__ __forceinline__ void tt_finish(const TDesc& d, int lane, const f32x4 (&a)[8], const f32x4 (&b)[8], LAS unsigned* scr) {
    const int q = lane & 15, kq = lane >> 4;
#pragma unroll
    for (int r = 0; r < 8; ++r) { const int kp = kq + 4 * r; v4u w; w.x = pk2(a[r][0], b[r][0]); w.y = pk2(a[r][1], b[r][1]); w.z = pk2(a[r][2], b[r][2]); w.w = pk2(a[r][3], b[r][3]);
        *(LAS v4u*)(scr + kp * 68 + 4 * q) = w; }
    LDS_WAIT(); asm volatile("" ::: "memory");
    const int nn = lane & 7, c = lane >> 3;
#pragma unroll
    for (int j = 0; j < 8; ++j) { const int n = nn + 8 * j; const LAS unsigned* s = scr + (4 * c) * 68 + n;
        v4u o; o.x = s[0]; o.y = s[68]; o.z = s[136]; o.w = s[204];
        *(v4u*)(d.dst + (size_t)n * d.ldt + 8 * c) = o; }
    LDS_WAIT(); asm volatile("" ::: "memory");
}
constexpr int TI_IN = 16 * 68, TI_AO = 8 * 16, TI_CO = 8 * 16, TI_OUT = 16 * 16, TI_R = 16 * 4, TI_GS = 16 * 4, TI_US = 16 * 4, TI_DS = 4 * 16;
constexpr int TI_SMALL = TI_IN + TI_AO + TI_CO + TI_OUT + TI_R + TI_GS + TI_US + TI_DS;
constexpr int TI_E = 64 * NEXP;
constexpr int TI_TOTAL = TI_SMALL + 3 * TI_E;
__device__ __forceinline__ TDesc transpose_desc(const Args& A, int it) {
    unsigned char* ws = A.ws;
    const float* W; int K, N; bf16* D; int rbase = 0, rstr = 128;
    int r = it;
    if (r < TI_IN) { W = A.w_in; K = 1024; N = IN_COLS; D = (bf16*)(ws + WS_WIN); }
    else if ((r -= TI_IN) < TI_AO) { W = A.w_attn_o; K = 512; N = 1024; D = (bf16*)(ws + WS_WAO); }
    else if ((r -= TI_AO) < TI_CO) { W = A.w_conv_o; K = 512; N = 1024; D = (bf16*)(ws + WS_WCO); }
    else if ((r -= TI_CO) < TI_OUT) { W = A.w_out; K = 1024; N = 1024; D = (bf16*)(ws + WS_WOUT); }
    else if ((r -= TI_OUT) < TI_R) { W = A.w_router; K = 1024; N = 256; D = (bf16*)(ws + WS_WRS); }
    else if ((r -= TI_R) < TI_GS) { W = A.w_gate_s; K = 1024; N = 256; D = (bf16*)(ws + WS_WRS); rbase = 256; rstr = 256; }
    else if ((r -= TI_GS) < TI_US) { W = A.w_up_s; K = 1024; N = 256; D = (bf16*)(ws + WS_WRS); rbase = 256 + 128; rstr = 256; }
    else if ((r -= TI_US) < TI_DS) { W = A.w_down_s; K = 256; N = 1024; D = (bf16*)(ws + WS_WSD); }
    else if ((r -= TI_DS) < TI_E) { const int e = r >> 6; r &= 63; W = A.w_gate_e + (size_t)e * 1024 * 256; K = 1024; N = 256; D = (bf16*)(ws + WS_WE1) + (size_t)e * 512 * 1024; rstr = 256; }
    else if ((r -= TI_E) < TI_E) { const int e = r >> 6; r &= 63; W = A.w_up_e + (size_t)e * 1024 * 256; K = 1024; N = 256; D = (bf16*)(ws + WS_WE1) + (size_t)e * 512 * 1024; rbase = 128; rstr = 256; }
    else { r -= TI_E; const int e = r >> 6; r &= 63; W = A.w_down_e + (size_t)e * 256 * 1024; K = 256; N = 1024; D = (bf16*)(ws + WS_WED) + (size_t)e * 1024 * 256; }
    const int ntn = N >> 6, kb = r / ntn, nb = r - kb * ntn, k0 = kb * 64, n0 = nb * 64;
    const int drow = rbase + (n0 >> 7) * rstr + (n0 & 127);
    TDesc d; d.src = W + (size_t)k0 * N + n0; d.dst = D + (size_t)drow * K + k0; d.N = N; d.ldt = K; return d;
}
__device__ __forceinline__ void transpose_all(const Args& A, int gw, int ngw, LAS unsigned* scr, int lane) {
    f32x4 a0[8], b0[8], a1[8], b1[8]; TDesc d0, d1;
    int it = gw;
    if (it < TI_TOTAL) { d0 = transpose_desc(A, it); tt_load(d0, lane, a0, b0); }
    while (it < TI_TOTAL) {
        const int it1 = it + ngw;
        if (it1 < TI_TOTAL) { d1 = transpose_desc(A, it1); tt_load(d1, lane, a1, b1); }
        tt_finish(d0, lane, a0, b0, scr);
        if (it1 >= TI_TOTAL) break;
        const int it2 = it1 + ngw;
        if (it2 < TI_TOTAL) { d0 = transpose_desc(A, it2); tt_load(d0, lane, a0, b0); }
        tt_finish(d1, lane, a1, b1, scr);
        it = it2;
    }
}
__device__ __forceinline__ void mod_item(const Args& A, int chunk, LAS unsigned char* lds, int tid, int wave, int lane) {
    LAS float* s = (LAS float*)lds;
    LAS float* red = (LAS float*)(lds + 65536);
    for (int i = tid; i < NB * DM; i += NWAVES * 64) { const float v = A.c[i]; s[i] = v / (1.0f + __expf(-v)); }
    __syncthreads();
    float acc[NB];
#pragma unroll
    for (int b = 0; b < NB; ++b) acc[b] = 0.f;
    const float* w = A.w_ada + (size_t)(wave * 128) * NMOD + chunk * 64 + lane;
#pragma unroll 2
    for (int k4 = 0; k4 < 128; k4 += 4) {
        float wv[4];
#pragma unroll
        for (int u = 0; u < 4; ++u) wv[u] = w[(size_t)(k4 + u) * NMOD];
#pragma unroll
        for (int b = 0; b < NB; ++b) { const f32x4 sv = *(const LAS f32x4*)(s + b * DM + wave * 128 + k4); acc[b] += sv[0] * wv[0]; acc[b] += sv[1] * wv[1]; acc[b] += sv[2] * wv[2]; acc[b] += sv[3] * wv[3]; }
    }
#pragma unroll
    for (int b = 0; b < NB; ++b) red[(wave * NB + b) * 64 + lane] = acc[b];
    __syncthreads();
    float* MOD = (float*)(A.ws + WS_MOD);
    for (int o = tid; o < NB * 64; o += NWAVES * 64) { const int b = o >> 6, cidx = o & 63; float v = 0.f;
#pragma unroll
        for (int wv = 0; wv < NWAVES; ++wv) v += red[(wv * NB + b) * 64 + cidx];
        MOD[(size_t)b * NMOD + chunk * 64 + cidx] = v + A.b_ada[chunk * 64 + cidx]; }
    __syncthreads();
}
__device__ __forceinline__ void norm_rows(const float* X, const float* g, const float* MOD, int sh_off, bf16* H, int gw, int ngw, int lane) {
    for (int m = gw; m < T; m += ngw) {
        const f32x4* xr = (const f32x4*)(X + (size_t)m * DM) + lane;
        f32x4 v[4]; float ss = 0.f;
#pragma unroll
        for (int j = 0; j < 4; ++j) { v[j] = xr[64 * j]; ss += (v[j][0] * v[j][0] + v[j][1] * v[j][1]) + (v[j][2] * v[j][2] + v[j][3] * v[j][3]); }
        const float rstd = rsqrtf(wave_sum(ss) * (1.0f / DM) + EPS);
        const float* mrow = MOD + (size_t)(m >> 11) * NMOD + sh_off;
        unsigned long long* o8 = (unsigned long long*)(H + (size_t)m * DM) + lane;
#pragma unroll
        for (int j = 0; j < 4; ++j) { const int col = 4 * lane + 256 * j;
            const f32x4 gg = *(const f32x4*)(g + col), sh = *(const f32x4*)(mrow + col), sc = *(const f32x4*)(mrow + DM + col);
            const f32x4 o = (v[j] * rstd) * gg * (sc + 1.0f) + sh;
            o8[64 * j] = (unsigned long long)pk2(o[0], o[1]) | ((unsigned long long)pk2(o[2], o[3]) << 32); }
    }
}
__device__ __forceinline__ void unpack8f(v4u w, float (&f)[8]) { f[0] = pg8::bf_lo(w.x); f[1] = pg8::bf_hi(w.x); f[2] = pg8::bf_lo(w.y); f[3] = pg8::bf_hi(w.y); f[4] = pg8::bf_lo(w.z); f[5] = pg8::bf_hi(w.z); f[6] = pg8::bf_lo(w.w); f[7] = pg8::bf_hi(w.w); }
__device__ __forceinline__ void qk_post(const Args& A, int gtid, int ngt) {
    bf16* Q = (bf16*)(A.ws + WS_Q); bf16* Kb = (bf16*)(A.ws + WS_K);
    const float* TC = (const float*)(A.ws + WS_TBL); const float* TS = TC + 64 * 16;
    constexpr int NQ = T * 8, NK = T * 2;
#pragma unroll 1
    for (int p = gtid; p < NQ + NK; p += ngt) {
        const bool isq = p < NQ; bf16* ptr = isq ? Q + (size_t)p * 64 : Kb + (size_t)(p - NQ) * 64; const int t = isq ? (p >> 3) : ((p - NQ) >> 1);
        const float* g = isq ? A.qg : A.kg; const float scale = isq ? attn_body::C2 : 1.0f;
        v4u w[8]; float ss = 0.f;
#pragma unroll
        for (int i = 0; i < 8; ++i) w[i] = ((const v4u*)ptr)[i];
#pragma unroll
        for (int i = 0; i < 8; ++i) { float f[8]; unpack8f(w[i], f);
#pragma unroll
            for (int u = 0; u < 8; ++u) ss += f[u] * f[u]; }
        const float r = rsqrtf(ss * (1.0f / 64.0f) + EPS) ;
        const int pr = (t & (SEQ - 1)) >> 6, pc = t & 63;
#pragma unroll
        for (int half = 0; half < 2; ++half) { const int pos = half ? pc : pr;
#pragma unroll
            for (int c = 0; c < 2; ++c) { const int d0 = 32 * half + 8 * c;
                float x1[8], x2[8], cs[8], sn[8], g1[8], g2[8];
                unpack8f(w[4 * half + c], x1); unpack8f(w[4 * half + c + 2], x2);
#pragma unroll
                for (int q4 = 0; q4 < 2; ++q4) { const f32x4 c4 = *(const f32x4*)(TC + pos * 16 + 8 * c + 4 * q4), s4 = *(const f32x4*)(TS + pos * 16 + 8 * c + 4 * q4);
                    const f32x4 ga = *(const f32x4*)(g + d0 + 4 * q4), gb = *(const f32x4*)(g + d0 + 16 + 4 * q4);
#pragma unroll
                    for (int u = 0; u < 4; ++u) { cs[4 * q4 + u] = c4[u]; sn[4 * q4 + u] = s4[u]; g1[4 * q4 + u] = ga[u]; g2[4 * q4 + u] = gb[u]; } }
                float o1[8], o2[8];
#pragma unroll
                for (int u = 0; u < 8; ++u) { const float y1 = x1[u] * r * g1[u], y2 = x2[u] * r * g2[u];
                    o1[u] = (y1 * cs[u] - y2 * sn[u]) * scale; o2[u] = (y2 * cs[u] + y1 * sn[u]) * scale; }
                v4u a, b; a.x = pk2(o1[0], o1[1]); a.y = pk2(o1[2], o1[3]); a.z = pk2(o1[4], o1[5]); a.w = pk2(o1[6], o1[7]);
                b.x = pk2(o2[0], o2[1]); b.y = pk2(o2[2], o2[3]); b.z = pk2(o2[4], o2[5]); b.w = pk2(o2[6], o2[7]);
                ((v4u*)ptr)[4 * half + c] = a; ((v4u*)ptr)[4 * half + c + 2] = b; } }
    }
}
__device__ __forceinline__ void load8(const bf16* p, float (&f)[8]) { const v4u w = *(const v4u*)p;
    f[0] = pg8::bf_lo(w.x); f[1] = pg8::bf_hi(w.x); f[2] = pg8::bf_lo(w.y); f[3] = pg8::bf_hi(w.y); f[4] = pg8::bf_lo(w.z); f[5] = pg8::bf_hi(w.z); f[6] = pg8::bf_lo(w.w); f[7] = pg8::bf_hi(w.w); }
__device__ __forceinline__ void conv_rows(const Args& A, int gw, int ngw, int lane) {
    bf16* CB = (bf16*)(A.ws + WS_CB); const bf16* CC = (const bf16*)(A.ws + WS_CC); const bf16* CX = (const bf16*)(A.ws + WS_CX);
    const int c0 = 8 * lane;
    float w0[8], w1[8], w2[8];
#pragma unroll
    for (int i = 0; i < 8; ++i) { w0[i] = A.conv_w[c0 + i]; w1[i] = A.conv_w[512 + c0 + i]; w2[i] = A.conv_w[1024 + c0 + i]; }
    for (int m = gw; m < T; m += ngw) {
        const int t = m & (SEQ - 1); const size_t off = (size_t)m * 512 + c0;
        float a[8], b[8], pc[8], pp[8], pn[8], cb[8];
        load8(CC + off, a); load8(CX + off, b);
#pragma unroll
        for (int i = 0; i < 8; ++i) pc[i] = a[i] * b[i];
        if (t > 0) { load8(CC + off - 512, a); load8(CX + off - 512, b);
#pragma unroll
            for (int i = 0; i < 8; ++i) pp[i] = a[i] * b[i]; }
        else {
#pragma unroll
            for (int i = 0; i < 8; ++i) pp[i] = 0.f; }
        if (t < SEQ - 1) { load8(CC + off + 512, a); load8(CX + off + 512, b);
#pragma unroll
            for (int i = 0; i < 8; ++i) pn[i] = a[i] * b[i]; }
        else {
#pragma unroll
            for (int i = 0; i < 8; ++i) pn[i] = 0.f; }
        load8(CB + off, cb);
        float u[8];
#pragma unroll
        for (int i = 0; i < 8; ++i) u[i] = cb[i] * (w0[i] * pp[i] + w1[i] * pc[i] + w2[i] * pn[i]);
        v4u w; w.x = pk2(u[0], u[1]); w.y = pk2(u[2], u[3]); w.z = pk2(u[4], u[5]); w.w = pk2(u[6], u[7]);
        *(v4u*)(CB + off) = w;
    }
}
__device__ __forceinline__ unsigned ord_f32(float f) { const unsigned u = __float_as_uint(f); return (u & 0x80000000u) ? ~u : (u | 0x80000000u); }
__device__ __forceinline__ float unord_f32(unsigned k) { return __uint_as_float((k & 0x80000000u) ? (k & 0x7fffffffu) : ~k); }
typedef unsigned long long u64;
__device__ __forceinline__ u64 max64(u64 a, u64 b) { return a > b ? a : b; }
template <int MASK> __device__ __forceinline__ u64 swz_xor_64(u64 v) { return ((u64)swz_xor_u<MASK>((unsigned)(v >> 32)) << 32) | (u64)swz_xor_u<MASK>((unsigned)v); }
__device__ __forceinline__ u64 max_group8(u64 v) { v = max64(v, swz_xor_64<1>(v)); v = max64(v, swz_xor_64<2>(v)); v = max64(v, swz_xor_64<4>(v)); return v; }
__device__ __forceinline__ u64 max_wave(u64 v) { v = max_group8(v); v = max64(v, swz_xor_64<8>(v)); v = max64(v, swz_xor_64<16>(v));
    auto lo = __builtin_amdgcn_permlane32_swap((unsigned)v, (unsigned)v, false, false); auto hi = __builtin_amdgcn_permlane32_swap((unsigned)(v >> 32), (unsigned)(v >> 32), false, false);
    return max64(((u64)hi[0] << 32) | lo[0], ((u64)hi[1] << 32) | lo[1]); }
template <int MASK> __device__ __forceinline__ unsigned umax_swz(unsigned v) { const unsigned o = swz_xor_u<MASK>(v); return v > o ? v : o; }
__device__ __forceinline__ unsigned umax_wave(unsigned v) { v = umax_swz<1>(v); v = umax_swz<2>(v); v = umax_swz<4>(v); v = umax_swz<8>(v); v = umax_swz<16>(v);
    auto rr = __builtin_amdgcn_permlane32_swap(v, v, false, false); return rr[0] > rr[1] ? rr[0] : rr[1]; }
template <int MASK> __device__ __forceinline__ void top2_swz(unsigned& m1, unsigned& m2) { const unsigned p1 = swz_xor_u<MASK>(m1), p2 = swz_xor_u<MASK>(m2);
    const unsigned lo = m1 < p1 ? m1 : p1, hi2 = m2 > p2 ? m2 : p2; m1 = m1 > p1 ? m1 : p1; m2 = lo > hi2 ? lo : hi2; }
constexpr int RT_TPW = 4;
__device__ __forceinline__ void route_tokens(const Args& A, LAS unsigned char* misc, int tid, int wave, int lane) {
    LAS int* lhist = (LAS int*)(misc + L_HIST);
    const float* SC = (const float*)(A.ws + WS_SC);
    int* IDX = (int*)(A.ws + WS_IDX); float* WTS = (float*)(A.ws + WS_WTS); int* SLOT = (int*)(A.ws + WS_SLOT); int* HIST = (int*)(A.ws + WS_HIST);
    if (tid < NEXP) lhist[tid] = 0;
    __syncthreads();
    const f32x4 bias = *(const f32x4*)(A.r_bias + 4 * lane);
    const int grp = lane >> 3;
#pragma unroll 1
    for (int i0 = 0; i0 < 16; i0 += RT_TPW) {
        const int t0 = blockIdx.x * 128 + wave * 16 + i0;
        f32x4 s[RT_TPW]; unsigned val[RT_TPW][4];
#pragma unroll
        for (int q = 0; q < RT_TPW; ++q) s[q] = *(const f32x4*)(SC + (size_t)(t0 + q) * NEXP + 4 * lane);
#pragma unroll
        for (int q = 0; q < RT_TPW; ++q) {
#pragma unroll
            for (int j = 0; j < 4; ++j) val[q][j] = ord_f32(s[q][j] + bias[j]);
            unsigned a = val[q][0] > val[q][1] ? val[q][0] : val[q][1], b = val[q][0] > val[q][1] ? val[q][1] : val[q][0];
            unsigned c = val[q][2] > val[q][3] ? val[q][2] : val[q][3], d = val[q][2] > val[q][3] ? val[q][3] : val[q][2];
            unsigned m1 = a > c ? a : c; const unsigned lo = a > c ? c : a, hi2 = b > d ? b : d; unsigned m2 = lo > hi2 ? lo : hi2;
            top2_swz<1>(m1, m2); top2_swz<2>(m1, m2); top2_swz<4>(m1, m2);
            const float gscore = unord_f32(m1) + unord_f32(m2);
            int rank = 0;
#pragma unroll
            for (int g = 0; g < 8; ++g) { const float og = bcast_f(gscore, 8 * g); rank += (og > gscore || (og == gscore && g < grp)) ? 1 : 0; }
            if (rank >= 4) {
#pragma unroll
                for (int j = 0; j < 4; ++j) val[q][j] = 0u; }
        }
        int my_e[RT_TPW]; float my_w[RT_TPW], wsum[RT_TPW];
#pragma unroll
        for (int q = 0; q < RT_TPW; ++q) { my_e[q] = 0; my_w[q] = 0.f; wsum[q] = 0.f; }
#pragma unroll
        for (int k = 0; k < TOPK; ++k) {
#pragma unroll
            for (int q = 0; q < RT_TPW; ++q) {
                const unsigned l01 = val[q][0] > val[q][1] ? val[q][0] : val[q][1], l23 = val[q][2] > val[q][3] ? val[q][2] : val[q][3];
                const unsigned lm = l01 > l23 ? l01 : l23;
                const unsigned wm = umax_wave(lm);
                const unsigned long long bal = __builtin_amdgcn_ballot_w64(lm == wm);
                const int L = (int)__builtin_ctzll(bal);
                const int jj = val[q][0] == wm ? 0 : val[q][1] == wm ? 1 : val[q][2] == wm ? 2 : 3;
                const float sv = jj == 0 ? s[q][0] : jj == 1 ? s[q][1] : jj == 2 ? s[q][2] : s[q][3];
                const int j = __builtin_amdgcn_readlane(jj, L); const float v = bcast_f(sv, L);
                if (lane == L) { if (j == 0) val[q][0] = 0u; else if (j == 1) val[q][1] = 0u; else if (j == 2) val[q][2] = 0u; else val[q][3] = 0u; }
                wsum[q] += v; if (lane == k) { my_e[q] = 4 * L + j; my_w[q] = v; }
            }
        }
        if (lane < TOPK) {
#pragma unroll
            for (int q = 0; q < RT_TPW; ++q) { const int t = t0 + q;
                IDX[t * TOPK + lane] = my_e[q]; WTS[t * TOPK + lane] = my_w[q] / wsum[q] * ROUTED_SCALE;
                SLOT[t * TOPK + lane] = atomicAdd((int*)&lhist[my_e[q]], 1); }
        }
    }
    __syncthreads();
    if (tid < NEXP) HIST[blockIdx.x * NEXP + tid] = lhist[tid];
}
typedef int i32x4 __attribute__((ext_vector_type(4)));
__device__ __forceinline__ void assign_slots(const Args& A, LAS unsigned char* lds, LAS unsigned char* misc, int tid, int wave, int lane) {
    LAS int* l_pad = (LAS int*)(misc + L_PAD); LAS int* l_base = (LAS int*)(misc + L_BASE); LAS int* l_ps = (LAS int*)(misc + L_PS);
    LAS int* pc = (LAS int*)lds; LAS int* pb = pc + NWAVES * NEXP; LAS int* sa = pb + NWAVES * NEXP;
    const int* HIST = (const int*)(A.ws + WS_HIST); const int* IDX = (const int*)(A.ws + WS_IDX);
    int* SLOT = (int*)(A.ws + WS_SLOT); int* SLOT_TOK = (int*)(A.ws + WS_SLOT_TOK); int* TILE_E = (int*)(A.ws + WS_TILE_E); unsigned* CTL = (unsigned*)(A.ws + WS_CTL);
    const int nb = (int)gridDim.x, bx = (int)blockIdx.x;
    { i32x4 cnt = (i32x4){0, 0, 0, 0}, bef = (i32x4){0, 0, 0, 0};
#pragma unroll 8
      for (int b = wave; b < nb; b += NWAVES) { const i32x4 h = *(const i32x4*)(HIST + b * NEXP + 4 * lane); cnt += h; if (b < bx) bef += h; }
      *(LAS i32x4*)(pc + wave * NEXP + 4 * lane) = cnt; *(LAS i32x4*)(pb + wave * NEXP + 4 * lane) = bef; }
    __syncthreads();
    int mypad = 0;
    if (tid < NEXP) { int cnt = 0, bef = 0;
#pragma unroll
        for (int w = 0; w < NWAVES; ++w) { cnt += pc[w * NEXP + tid]; bef += pb[w * NEXP + tid]; }
        mypad = (cnt + 255) & ~255; l_pad[tid] = mypad; l_base[tid] = bef; sa[tid] = mypad; }
    __syncthreads();
#pragma unroll 1
    for (int d = 1; d < NEXP; d <<= 1) {
        int v = 0; if (tid < NEXP) v = sa[tid] + (tid >= d ? sa[tid - d] : 0);
        __syncthreads();
        if (tid < NEXP) sa[tid] = v;
        __syncthreads();
    }
    if (tid < NEXP) { l_ps[tid] = sa[tid] - mypad; if (tid == NEXP - 1) l_ps[NEXP] = sa[tid]; }
    __syncthreads();
    if (bx == 0) {
        if (tid < NEXP) { const int t0 = l_ps[tid] >> 8, n = l_pad[tid] >> 8; for (int i = 0; i < n; ++i) TILE_E[t0 + i] = tid; }
        if (tid == 0) CTL[CW_NTILES] = (unsigned)(l_ps[NEXP] >> 8);
    }
    for (int a = tid; a < 128 * TOPK; a += NWAVES * 64) { const int j = bx * 128 * TOPK + a; const int e = IDX[j];
        const int slot = l_ps[e] + l_base[e] + SLOT[j]; SLOT[j] = slot; SLOT_TOK[slot] = j >> 3; }
}
__device__ __forceinline__ void combine_rows(const Args& A, int gw, int ngw, int lane) {
    const bf16* Y = (const bf16*)(A.ws + WS_Y); const int* SLOT = (const int*)(A.ws + WS_SLOT); const float* WTS = (const float*)(A.ws + WS_WTS);
    const float* MOD = (const float*)(A.ws + WS_MOD);
    for (int m = gw; m < T; m += ngw) {
        int sl = 0; float wt = 0.f;
        if (lane < TOPK) { sl = SLOT[m * TOPK + lane]; wt = WTS[m * TOPK + lane]; }
        float acc[16];
#pragma unroll
        for (int i = 0; i < 16; ++i) acc[i] = 0.f;
#pragma unroll
        for (int k = 0; k < TOPK; ++k) { const int s = __builtin_amdgcn_readlane(sl, k); const float w = bcast_f(wt, k); const bf16* yr = Y + (size_t)s * DM + 8 * lane;
            float f0[8], f1[8]; load8(yr, f0); load8(yr + 512, f1);
#pragma unroll
            for (int i = 0; i < 8; ++i) { acc[i] += w * f0[i]; acc[8 + i] += w * f1[i]; } }
        const float* gt = MOD + (size_t)(m >> 11) * NMOD + 5 * DM + 8 * lane;
        float* o = A.out + (size_t)m * DM + 8 * lane;
#pragma unroll
        for (int h = 0; h < 2; ++h)
#pragma unroll
            for (int q = 0; q < 2; ++q) { const f32x4 g4 = *(const f32x4*)(gt + 512 * h + 4 * q), x4 = *(const f32x4*)(o + 512 * h + 4 * q);
                const f32x4 a4 = (f32x4){acc[8 * h + 4 * q], acc[8 * h + 4 * q + 1], acc[8 * h + 4 * q + 2], acc[8 * h + 4 * q + 3]};
                *(f32x4*)(o + 512 * h + 4 * q) = x4 + g4 * a4; }
    }
}

__global__ void __launch_bounds__(NWAVES * 64, 2) fwd_megakernel(Args Araw) {
    extern __shared__ __attribute__((aligned(16))) unsigned char lds_raw[];
    typedef const __attribute__((address_space(4))) Args* CArgs;
    cg::grid_group grid = cg::this_grid();
    LAS unsigned char* lds = (LAS unsigned char*)lds_raw;
    LAS unsigned char* misc = lds + MISC_OFF;
    const int wave_s = __builtin_amdgcn_readfirstlane((int)threadIdx.x >> 6);
#define LANE_ID() ({ unsigned z_ = 0u; asm volatile("" : "+v"(z_)); (int)__builtin_amdgcn_mbcnt_hi(~0u, __builtin_amdgcn_mbcnt_lo(~0u, z_)); })
    XcdBarrier xbar;
    { const int tid0 = wave_s * 64 + LANE_ID();
      volatile LAS unsigned* st = (volatile LAS unsigned*)(misc + L_BARST);
      if (tid0 < 2) st[tid0] = 0u;
      __syncthreads();
      CArgs ap0 = (CArgs)__builtin_amdgcn_kernarg_segment_ptr(); unsigned char* ws0 = ap0->ws;
      xbar = xcd_barrier_post((unsigned*)(ws0 + WS_CTL) + CW_BAR, st, tid0); }
#if defined(__HIP_DEVICE_COMPILE__)
#define PHASE_ARGS CArgs ap_ = (CArgs)__builtin_amdgcn_kernarg_segment_ptr(); asm volatile("" : "+s"(ap_)); const Args A = *ap_; unsigned char* const ws = A.ws; float* const MOD = (float*)(ws + WS_MOD); (void)MOD;
#else
#define PHASE_ARGS const Args A = Araw; unsigned char* const ws = A.ws; float* const MOD = (float*)(ws + WS_MOD); (void)MOD;
#endif
#define PHASE_IDS const int wave = wave_s; int tid = wave_s * 64 + LANE_ID(); asm volatile("" : "+v"(tid)); const int lane = tid & 63; \
    int G = gridDim.x, bx = blockIdx.x; asm volatile("" : "+s"(G), "+s"(bx)); const int vcu = (G % 8 == 0) ? (bx % 8) * (G / 8) + bx / 8 : bx; const int gw = vcu * NWAVES + wave, ngw = G * NWAVES; \
    (void)lane; (void)gw; (void)ngw;
#define GRID_SYNC() do { const int tb_ = wave_s * 64 + LANE_ID(); xcd_barrier(xbar, tb_); } while (0)
#define PH(n) ((PHMASK >> (n)) & 1)

    if (PH(0)) { PHASE_ARGS PHASE_IDS
        if (bx < NMOD / 64) mod_item(A, bx, lds, tid, wave, lane);
        { LAS unsigned* scr = (LAS unsigned*)(lds + wave * 8704);
          transpose_all(A, gw, ngw, scr, lane); }
        { float* TC = (float*)(ws + WS_TBL); float* TS = TC + 64 * 16;
          const int gt_ = bx * NWAVES * 64 + tid;
          if (gt_ < 64 * 16) { const int pos = gt_ >> 4, i = gt_ & 15; const float inv = powf(10000.0f, -(float)(2 * i) / 32.0f); const float ang = (float)pos * inv; TC[gt_] = cosf(ang); TS[gt_] = sinf(ang); }
          int* SLOT_TOK = (int*)(ws + WS_SLOT_TOK);
          for (int i = gt_; i < NSLOT_MAX; i += G * NWAVES * 64) SLOT_TOK[i] = 0; }
    }
    GRID_SYNC();
    if (PH(1)) { PHASE_ARGS PHASE_IDS
        norm_rows(A.x, A.g_mix, MOD, 0, (bf16*)(ws + WS_H), gw, ngw, lane);
    }
    GRID_SYNC();
    if (PH(2)) { PHASE_ARGS PHASE_IDS
        pg8::Gemm g{(const bf16*)(ws + WS_H), (const bf16*)(ws + WS_WIN), DM, DM, nullptr}; pg8::StaticOrder S; S.init(T, IN_COLS, G, bx);
        pg8::EpiProj E{ws, WS_Q, WS_K, WS_V, WS_CB, WS_CC, WS_CX, WS_SGA, WS_SGC};
        pg8::gemm_phase<pg8::EpiProj, pg8::StaticOrder, false>(lds, g, S, E, tid);
    }
    GRID_SYNC();
    if (PH(3)) { PHASE_ARGS PHASE_IDS
        qk_post(A, bx * NWAVES * 64 + tid, G * NWAVES * 64);
        conv_rows(A, gw, ngw, lane);
    }
    GRID_SYNC();
    if (PH(4)) { PHASE_ARGS PHASE_IDS
        const attn_body::AttnTensors AT{(const attn_body::bf16*)(ws + WS_Q), (const attn_body::bf16*)(ws + WS_K), (const attn_body::bf16*)(ws + WS_V), (attn_body::bf16*)(ws + WS_O)};
        const attn_body::StaticOrder S(G, bx);
        attn_body::attn_phase<attn_body::StaticOrder>((char*)lds_raw, AT, S, tid);
    }
    GRID_SYNC();
    if (PH(5)) {
        { PHASE_ARGS PHASE_IDS pg8::StaticOrder S; S.init(T, DM, G, bx); pg8::Gemm g{(const bf16*)(ws + WS_O), (const bf16*)(ws + WS_WAO), 512, 512, nullptr}; pg8::EpiGate<false> E{(const bf16*)(ws + WS_SGA), (bf16*)(ws + WS_MG)};
          pg8::gemm_phase<pg8::EpiGate<false>, pg8::StaticOrder, false>(lds, g, S, E, tid); }
        { PHASE_ARGS PHASE_IDS pg8::StaticOrder S; S.init(T, DM, G, bx); pg8::Gemm g{(const bf16*)(ws + WS_CB), (const bf16*)(ws + WS_WCO), 512, 512, nullptr}; pg8::EpiGate<true> E{(const bf16*)(ws + WS_SGC), (bf16*)(ws + WS_MG)};
          pg8::gemm_phase<pg8::EpiGate<true>, pg8::StaticOrder, false>(lds, g, S, E, tid); }
    }
    GRID_SYNC();
    if (PH(6)) { PHASE_ARGS PHASE_IDS
        pg8::Gemm g{(const bf16*)(ws + WS_MG), (const bf16*)(ws + WS_WOUT), DM, DM, nullptr}; pg8::StaticOrder S; S.init(T, DM, G, bx);
        pg8::EpiResid<false> E{A.x, A.out, MOD + 2 * DM};
        pg8::gemm_phase<pg8::EpiResid<false>, pg8::StaticOrder, false>(lds, g, S, E, tid);
    }
    GRID_SYNC();
    if (PH(7)) { PHASE_ARGS PHASE_IDS
        norm_rows(A.out, A.g_ffn, MOD, 3 * DM, (bf16*)(ws + WS_H), gw, ngw, lane);
    }
    GRID_SYNC();
    if (PH(8)) { PHASE_ARGS PHASE_IDS
        pg8::Gemm g{(const bf16*)(ws + WS_H), (const bf16*)(ws + WS_WRS), DM, DM, nullptr}; pg8::StaticOrder S; S.init(T, 768, G, bx);
        pg8::EpiRouterShared E{(float*)(ws + WS_SC), (bf16*)(ws + WS_HS)};
        pg8::gemm_phase<pg8::EpiRouterShared, pg8::StaticOrder, false>(lds, g, S, E, tid);
    }
    GRID_SYNC();
    if (PH(9)) {
        { PHASE_ARGS PHASE_IDS route_tokens(A, misc, tid, wave, lane); }
        { PHASE_ARGS PHASE_IDS pg8::Gemm g{(const bf16*)(ws + WS_HS), (const bf16*)(ws + WS_WSD), EFF, EFF, nullptr}; pg8::StaticOrder S; S.init(T, DM, G, bx);
          pg8::EpiResid<true> E{A.out, A.out, MOD + 5 * DM};
          pg8::gemm_phase<pg8::EpiResid<true>, pg8::StaticOrder, false>(lds, g, S, E, tid); }
    }
    GRID_SYNC();
    if (PH(10)) { PHASE_ARGS PHASE_IDS
        assign_slots(A, lds, misc, tid, wave, lane);
    }
    GRID_SYNC();
    if (PH(11)) { PHASE_ARGS PHASE_IDS
        const int ntiles = (int)__hip_atomic_load((unsigned*)(ws + WS_CTL) + CW_NTILES, __ATOMIC_RELAXED, __HIP_MEMORY_SCOPE_AGENT);
        LAS int* tileE = (LAS int*)(misc + L_TILEE);
        { const int* TILE_E = (const int*)(ws + WS_TILE_E); for (int i = tid; i < ntiles; i += NWAVES * 64) tileE[i] = TILE_E[i]; }
        __syncthreads();
        pg8::Gemm g{(const bf16*)(ws + WS_H), (const bf16*)(ws + WS_WE1), DM, DM, (const int*)(ws + WS_SLOT_TOK)};
        pg8::DynOrder S{ntiles * 2, G, bx, 2, tileE};
        pg8::EpiExpert1 E{(bf16*)(ws + WS_HID)};
        pg8::gemm_phase<pg8::EpiExpert1, pg8::DynOrder, true>(lds, g, S, E, tid);
    }
    GRID_SYNC();
    if (PH(12)) { PHASE_ARGS PHASE_IDS
        const int ntiles = (int)__hip_atomic_load((unsigned*)(ws + WS_CTL) + CW_NTILES, __ATOMIC_RELAXED, __HIP_MEMORY_SCOPE_AGENT);
        LAS int* tileE = (LAS int*)(misc + L_TILEE);
        { const int* TILE_E = (const int*)(ws + WS_TILE_E); for (int i = tid; i < ntiles; i += NWAVES * 64) tileE[i] = TILE_E[i]; }
        __syncthreads();
        pg8::Gemm g{(const bf16*)(ws + WS_HID), (const bf16*)(ws + WS_WED), EFF, EFF, nullptr};
        pg8::DynOrder S{ntiles * 4, G, bx, 4, tileE};
        pg8::EpiExpert2 E{(bf16*)(ws + WS_Y)};
        pg8::gemm_phase<pg8::EpiExpert2, pg8::DynOrder, false>(lds, g, S, E, tid);
    }
    GRID_SYNC();
    if (PH(13)) { PHASE_ARGS PHASE_IDS
        combine_rows(A, gw, ngw, lane);
    }
}

extern "C" void kernel_launch(void* const* d_in, const int* in_sizes, int n_in, void* d_out, int out_size, void* d_ws, size_t ws_size, hipStream_t stream) {
    static int grid = 0;
    if (grid == 0) {
        if (n_in != 21 || in_sizes[0] != T * DM || out_size != T * DM || ws_size < WS_END) { fprintf(stderr, "kernel_launch: unexpected problem shape or workspace (%zu < %zu); nothing launched\n", ws_size, (size_t)WS_END); grid = -1; return; }
        int dev = 0, cus = 0, per_cu = 0;
        if (hipGetDevice(&dev) != hipSuccess || hipDeviceGetAttribute(&cus, hipDeviceAttributeMultiprocessorCount, dev) != hipSuccess) { grid = -1; return; }
        if (hipFuncSetAttribute((const void*)fwd_megakernel, hipFuncAttributeMaxDynamicSharedMemorySize, LDS_BYTES) != hipSuccess) { fprintf(stderr, "kernel_launch: hipFuncSetAttribute failed\n"); grid = -1; return; }
        if (hipOccupancyMaxActiveBlocksPerMultiprocessor(&per_cu, (const void*)fwd_megakernel, NWAVES * 64, LDS_BYTES) != hipSuccess || per_cu < 1) { fprintf(stderr, "kernel_launch: occupancy query says %d blocks per CU\n", per_cu); (void)hipGetLastError(); grid = -1; return; }
        grid = cus;
        if (grid != 256) { fprintf(stderr, "kernel_launch: built for a 256-CU device, found %d CUs; nothing launched\n", cus); grid = -1; return; }
    }
    if (grid < 0) return;
    if (hipMemsetAsync((char*)d_ws + WS_CTL, 0, CTL_ZERO_BYTES, stream) != hipSuccess) { fprintf(stderr, "kernel_launch: hipMemsetAsync failed\n"); return; }
    Args a{};
    const float** p = (const float**)&a;
    for (int i = 0; i < 21; ++i) p[i] = (const float*)d_in[i];
    a.out = (float*)d_out; a.ws = (unsigned char*)d_ws;
    void* args[] = {&a};
    const hipError_t e = hipLaunchCooperativeKernel((const void*)fwd_megakernel, dim3(grid), dim3(NWAVES * 64), args, LDS_BYTES, stream);
    if (e != hipSuccess) fprintf(stderr, "kernel_launch: cooperative launch failed: %s (grid %d)\n", hipGetErrorString(e), grid);
}
```
